# Optimizing an MI355X kernel written in HIP

```python
import math
import jax, jax.numpy as jnp
from jax import lax
import numpy as np

D_MODEL = 1024
BATCH = 8
SEQ = 4096
DEPTH = 4

D_MIX = D_MODEL
ATT_HEADS = 4
ATT_QK_DIM = 64
ATT_V_DIM = 128
ATT_WIDTH = ATT_HEADS * ATT_V_DIM
ATT_QK_COLS = ATT_HEADS * 2 * ATT_QK_DIM
CONV_WIDTH = D_MIX // 4
CONV_K = 3
RWKV_HEAD = 64
RWKV_WIDTH = D_MIX // 4
RWKV_HEADS = RWKV_WIDTH // RWKV_HEAD
DECAY_LORA = 64
ICLR_LORA = 64
RWKV_SHIFT_COLS = 3 * RWKV_WIDTH + DECAY_LORA + ICLR_LORA
IN_COLS = 2 * ATT_QK_COLS + 2 * ATT_WIDTH + 4 * CONV_WIDTH + RWKV_SHIFT_COLS + RWKV_WIDTH
N_BUCKETS = 32
MAX_DISTANCE = 128
Q_BLOCK = 128
NEG_INF = -1e30
NORM_EPS = 1e-6
SUBLN_EPS = 1e-5
GN_EPS = 64e-5

kernel_name = 'hybrid_diffattn_shortconv_rwkv7'


def rmsnorm(x, g, eps=NORM_EPS):
    xf = x.astype(jnp.float32)
    y = xf * lax.rsqrt(jnp.mean(xf * xf, axis=-1, keepdims=True) + eps)
    return (y * g.astype(jnp.float32)).astype(x.dtype)


def split_cols(p, sizes):
    out, start = [], 0
    for n in sizes:
        out.append(p[..., start:start + n])
        start += n
    return out


def t5_causal_bucket(dist):
    n = jnp.maximum(dist, 0)
    max_exact = N_BUCKETS // 2
    nf = jnp.maximum(n, 1).astype(jnp.float32)
    large = max_exact + (jnp.log(nf / max_exact) / math.log(MAX_DISTANCE / max_exact)
                         * (N_BUCKETS - max_exact)).astype(jnp.int32)
    large = jnp.minimum(large, N_BUCKETS - 1)
    return jnp.where(n < max_exact, n, large)


def diff_attention(q, k, v, lam, lambda_init, subln_g, rel_bias):
    b, s, h = q.shape[0], q.shape[1], q.shape[2]
    nb = s // Q_BLOCK
    scale = ATT_QK_DIM ** -0.5
    qf = (q.astype(jnp.float32) * scale).reshape(b, nb, Q_BLOCK, h, 2, ATT_QK_DIM).swapaxes(0, 1)
    kf = k.astype(jnp.float32)
    vf = v.astype(jnp.float32)
    table = rel_bias.astype(jnp.float32)
    key_pos = jnp.arange(s)

    def block(args):
        qb, i = args
        q_pos = i * Q_BLOCK + jnp.arange(Q_BLOCK)
        dist = q_pos[:, None] - key_pos[None, :]
        bias = jnp.transpose(table[t5_causal_bucket(dist)], (2, 0, 1))
        logits = jnp.einsum('bqhmd,bkhmd->bhmqk', qb, kf) + bias[None, :, None]
        logits = jnp.where(dist >= 0, logits, NEG_INF)
        p = jax.nn.softmax(logits, axis=-1)
        a = p[:, :, 0] - lam * p[:, :, 1]
        return jnp.einsum('bhqk,bkhd->bqhd', a, vf)

    o = lax.map(block, (qf, jnp.arange(nb)))
    o = o.swapaxes(0, 1).reshape(b, s, h, ATT_V_DIM)
    o = rmsnorm(o, subln_g, eps=SUBLN_EPS) * (1.0 - lambda_init)
    return o.reshape(b, s, h * ATT_V_DIM)


def short_conv(bg, cg, hin, conv_w):
    u = cg * hin
    kern = conv_w[:, None, :].astype(u.dtype)
    y = lax.conv_general_dilated(u, kern, window_strides=(1,), padding=[(CONV_K - 1, 0)],
                                 dimension_numbers=('NWC', 'WIO', 'NWC'),
                                 feature_group_count=u.shape[-1])
    return bg * y


def rwkv7_time_mix(p, mu, w0, w_up, a0, a_up, k_k, k_a, r_k, lnx_g, lnx_b):
    b, s, _ = p.shape
    f32 = jnp.float32
    p = p.astype(f32)
    prev = jnp.pad(p, ((0, 0), (1, 0), (0, 0)))[:, :-1]
    p = p + (prev - p) * mu.astype(f32)
    r, k, v, wd, ad = split_cols(p, (RWKV_WIDTH, RWKV_WIDTH, RWKV_WIDTH, DECAY_LORA, ICLR_LORA))
    w = -jax.nn.softplus(-(w0.astype(f32) + jnp.tanh(wd) @ w_up.astype(f32))) - 0.5
    decay = jnp.exp(-jnp.exp(w))
    a = jax.nn.sigmoid(a0.astype(f32) + ad @ a_up.astype(f32))
    heads = lambda t: t.reshape(b, s, RWKV_HEADS, RWKV_HEAD)
    kk = heads(k * k_k.astype(f32))
    kk = kk / jnp.maximum(jnp.sqrt(jnp.sum(kk * kk, axis=-1, keepdims=True)), 1e-12)
    k = k * (1.0 + (a - 1.0) * k_a.astype(f32))
    rh, kh, vh, wh, ah = heads(r), heads(k), heads(v), heads(decay), heads(a)

    def step(state, inp):
        r_t, k_t, v_t, w_t, kk_t, a_t = inp
        sa = jnp.einsum('bhvk,bhk->bhv', state, kk_t)
        state = (state * w_t[:, :, None, :]
                 - sa[..., None] * (kk_t * a_t)[:, :, None, :]
                 + v_t[..., None] * k_t[:, :, None, :])
        y = jnp.einsum('bhvk,bhk->bhv', state, r_t)
        return state, y

    xs = tuple(t.swapaxes(0, 1) for t in (rh, kh, vh, wh, kk, ah))
    s0 = jnp.zeros((b, RWKV_HEADS, RWKV_HEAD, RWKV_HEAD), f32)
    _, y = lax.scan(step, s0, xs)
    y = y.swapaxes(0, 1)
    mean = jnp.mean(y, axis=-1, keepdims=True)
    var = jnp.mean(jnp.square(y - mean), axis=-1, keepdims=True)
    y = (y - mean) * lax.rsqrt(var + GN_EPS)
    y = y.reshape(b, s, RWKV_WIDTH) * lnx_g.astype(f32) + lnx_b.astype(f32)
    bonus = jnp.sum(rh * kh * r_k.astype(f32), axis=-1, keepdims=True) * vh
    return y + bonus.reshape(b, s, RWKV_WIDTH)


def setup_inputs(seed: int = 0) -> dict:
    key = jax.random.key(seed)
    ks = jax.random.split(key, 20)
    nrm = jax.random.normal
    return {
        'x': nrm(ks[0], (BATCH, SEQ, D_MODEL), jnp.float32),
        'norm_g': 1.0 + 0.02 * nrm(ks[1], (DEPTH, D_MODEL), jnp.float32),
        'w_in': nrm(ks[2], (DEPTH, D_MODEL, IN_COLS), jnp.float32) * D_MODEL ** -0.5,
        'w_out': nrm(ks[3], (DEPTH, D_MIX, D_MODEL), jnp.float32) * D_MIX ** -0.5,
        'final_norm_g': 1.0 + 0.02 * nrm(ks[4], (D_MODEL,), jnp.float32),
        'rel_bias': 0.2 * nrm(ks[5], (N_BUCKETS, ATT_HEADS), jnp.float32),
        'lam_qk': 0.1 * nrm(ks[6], (DEPTH, 4, ATT_QK_DIM), jnp.float32),
        'subln_g': 1.0 + 0.02 * nrm(ks[7], (DEPTH, ATT_V_DIM), jnp.float32),
        'conv_w': nrm(ks[8], (DEPTH, CONV_K, CONV_WIDTH), jnp.float32) * CONV_K ** -0.5,
        'rwkv_mu': jax.random.uniform(ks[9], (DEPTH, RWKV_SHIFT_COLS), jnp.float32),
        'w0': jax.random.uniform(ks[10], (DEPTH, RWKV_WIDTH), jnp.float32, minval=-5.0, maxval=1.0),
        'w_up': 0.5 * nrm(ks[11], (DEPTH, DECAY_LORA, RWKV_WIDTH), jnp.float32) * DECAY_LORA ** -0.5,
        'a0': 0.1 * nrm(ks[12], (DEPTH, RWKV_WIDTH), jnp.float32),
        'a_up': 0.5 * nrm(ks[13], (DEPTH, ICLR_LORA, RWKV_WIDTH), jnp.float32) * ICLR_LORA ** -0.5,
        'k_k': 0.85 + 0.02 * nrm(ks[14], (DEPTH, RWKV_WIDTH), jnp.float32),
        'k_a': 1.0 + 0.02 * nrm(ks[15], (DEPTH, RWKV_WIDTH), jnp.float32),
        'r_k': 0.1 * nrm(ks[16], (DEPTH, RWKV_HEADS, RWKV_HEAD), jnp.float32),
        'lnx_g': 1.0 + 0.02 * nrm(ks[17], (DEPTH, RWKV_WIDTH), jnp.float32),
        'lnx_b': 0.01 * nrm(ks[18], (DEPTH, RWKV_WIDTH), jnp.float32),
    }


def reference(x, norm_g, w_in, w_out, final_norm_g, rel_bias, lam_qk, subln_g, conv_w,
              rwkv_mu, w0, w_up, a0, a_up, k_k, k_a, r_k, lnx_g, lnx_b):
    b, s, _ = x.shape
    sizes = (ATT_QK_COLS, ATT_QK_COLS, ATT_WIDTH, ATT_WIDTH,
             CONV_WIDTH, CONV_WIDTH, CONV_WIDTH, CONV_WIDTH,
             RWKV_SHIFT_COLS, RWKV_WIDTH)
    for l in range(DEPTH):
        h = rmsnorm(x, norm_g[l])
        p = h @ w_in[l]
        q, k, v, z_att, cb, cc, ch, z_conv, rw_p, z_rwkv = split_cols(p, sizes)
        lambda_init = 0.8 - 0.6 * math.exp(-0.3 * l)
        lq = lam_qk[l].astype(jnp.float32)
        lam = jnp.exp(jnp.sum(lq[0] * lq[1])) - jnp.exp(jnp.sum(lq[2] * lq[3])) + lambda_init
        att = diff_attention(q.reshape(b, s, ATT_HEADS, 2, ATT_QK_DIM),
                             k.reshape(b, s, ATT_HEADS, 2, ATT_QK_DIM),
                             v.reshape(b, s, ATT_HEADS, ATT_V_DIM),
                             lam, lambda_init, subln_g[l], rel_bias).astype(x.dtype)
        cv = short_conv(cb, cc, ch, conv_w[l])
        rw = rwkv7_time_mix(rw_p, rwkv_mu[l], w0[l], w_up[l], a0[l], a_up[l], k_k[l], k_a[l],
                            r_k[l], lnx_g[l], lnx_b[l]).astype(x.dtype)
        mixed = jnp.concatenate([att * jax.nn.silu(z_att),
                                 cv * jax.nn.silu(z_conv),
                                 rw * jax.nn.silu(z_rwkv)], axis=-1)
        x = x + mixed @ w_out[l]
    return rmsnorm(x, final_norm_g)
```

```cpp
#include <hip/hip_runtime.h>
#include <hip/hip_cooperative_groups.h>
#include <cstdio>
#include <cstdint>
namespace cg = cooperative_groups;

#ifndef ONE_LAUNCH
#define ONE_LAUNCH 1
#endif

typedef unsigned short u16;
typedef __bf16 bf2_t __attribute__((ext_vector_type(2)));
typedef float f2_t __attribute__((ext_vector_type(2)));
using bf16x8 = __attribute__((ext_vector_type(8))) short;
using f32x16 = __attribute__((ext_vector_type(16))) float;
using u32x4 = __attribute__((ext_vector_type(4))) unsigned;
#define DI __device__ __forceinline__
#define MFMA32(a, b, c) __builtin_amdgcn_mfma_f32_32x32x16_bf16((a), (b), (c), 0, 0, 0)

constexpr int NB = 8, SEQ = 4096, DM = 1024, DEPTH = 4, NTOK = NB * SEQ;
constexpr int INC = 4224, PS = 3712;
constexpr int PC_Q = 0, PC_K = 512, PC_ZATT = 1024, PC_CB = 1536, PC_CC = 1792, PC_CH = 2048, PC_ZCONV = 2304,
              PC_RW = 2560, PC_ZRW = 3456;
constexpr int SMEM_BYTES = 65536 + 1024;
constexpr int PPL = 7;
constexpr int N_PHASES = 2 + PPL * DEPTH;
constexpr int SCAN_T1 = 1344;
constexpr int G1_SPLIT = 16;
constexpr int N_SCAN_ITEMS = 128, N_ATT_ITEMS = 1024;

struct Params {
  const float *x, *norm_g, *w_in, *w_out, *final_g, *rel_bias, *lam_qk, *subln_g, *conv_w, *mu, *w0, *w_up, *a0,
      *a_up, *k_k, *k_a, *r_k, *lnx_g, *lnx_b;
  float* out;
  u16 *wt_in, *wt_out, *hbuf, *pbuf, *vT, *mixed;
  u16 *s_kk, *s_bb, *s_kx, *s_wr;
  float *s_w, *s_v, *s_sc, *s_state;
  unsigned *ctr, *bar;
};

DI unsigned pack_bf16(float a, float b) {
  f2_t v = {a, b};
  return __builtin_bit_cast(unsigned, __builtin_convertvector(v, bf2_t));
}
DI u16 to_bf16(float a) { return (u16)(pack_bf16(a, 0.f) & 0xffffu); }
DI float bf_lo(unsigned u) { return __uint_as_float(u << 16); }
DI float bf_hi(unsigned u) { return __uint_as_float(u & 0xffff0000u); }
DI float bf2f(u16 u) { return __uint_as_float(((unsigned)u) << 16); }
template <int CTRL, int RMASK>
DI float dpp_add(float v) {
  const int x = __builtin_amdgcn_update_dpp(0, __builtin_bit_cast(int, v), CTRL, RMASK, 0xF, true);
  return v + __builtin_bit_cast(float, x);
}
DI float wave_sum(float v) {
  v = dpp_add<0xB1, 0xF>(v);
  v = dpp_add<0x4E, 0xF>(v);
  v = dpp_add<0x124, 0xF>(v);
  v = dpp_add<0x128, 0xF>(v);
  v = dpp_add<0x142, 0xA>(v);
  v = dpp_add<0x143, 0xC>(v);
  return __builtin_bit_cast(float, __builtin_amdgcn_readlane(__builtin_bit_cast(int, v), 63));
}
DI int crow(int i, int h) { return (i & 3) + 8 * (i >> 2) + 4 * h; }
DI float silu(float z) { return z / (1.f + __expf(-z)); }

#define XB_TMO 128
#define XB_XCNT(j) (256 + 64 * (j))
#define XB_XSUB(j) (1280 + 64 * (j))
#define XB_XGEN(j) (2304 + 64 * (j))
#define XB_TOP 3328
#define XB_TOPGEN 3392
#define XCD_BAR_WORDS 3456
#define XB_SPIN_CAP (1u << 22)
DI unsigned xb_ld(unsigned* p) { return __hip_atomic_load(p, __ATOMIC_RELAXED, __HIP_MEMORY_SCOPE_AGENT); }
DI unsigned xb_add(unsigned* p, unsigned v) {
  return __hip_atomic_fetch_add(p, v, __ATOMIC_RELAXED, __HIP_MEMORY_SCOPE_AGENT);
}
DI unsigned xb_xcc_id() { return (unsigned)__builtin_amdgcn_s_getreg((3 << 11) | 20) & 0xFu; }
#define XB_SPIN(cond, bar)                                  \
  do {                                                      \
    unsigned _sp = 0;                                       \
    while (cond) {                                          \
      __builtin_amdgcn_s_sleep(1);                          \
      if ((++_sp & 255u) == 0u) {                           \
        if (xb_ld(&(bar)[XB_TMO])) break;                   \
        if (_sp > XB_SPIN_CAP) {                            \
          atomicAdd(&(bar)[XB_TMO], 1u);                    \
          break;                                            \
        }                                                   \
      }                                                     \
    }                                                       \
  } while (0)

struct XcdBarrier {
  unsigned* bar;
  unsigned x;
  volatile unsigned* st;
};
DI XcdBarrier xcd_barrier_post(unsigned* bar, volatile unsigned* st) {
  XcdBarrier b;
  b.bar = bar;
  b.x = xb_xcc_id();
  b.st = st;
  if (threadIdx.x == 0) (void)xb_add(&bar[XB_XCNT(b.x)], 1u);
  return b;
}
DI void xcd_barrier_complete(unsigned* bar, unsigned x, unsigned& nloc, unsigned& nx) {
  const unsigned G = gridDim.x;
  unsigned sum, cnt, mine, sp = 0u;
  for (;;) {
    sum = 0u; cnt = 0u; mine = 0u;
#pragma unroll
    for (unsigned j = 0; j < 16; ++j) {
      const unsigned c = xb_ld(&bar[XB_XCNT(j)]);
      sum += c; cnt += (c > 0u) ? 1u : 0u; mine = (j == x) ? c : mine;
    }
    if (sum == G) break;
    __builtin_amdgcn_s_sleep(1);
    if ((++sp & 255u) == 0u) {
      if (xb_ld(&bar[XB_TMO])) break;
      if (sp > XB_SPIN_CAP) { atomicAdd(&bar[XB_TMO], 1u); break; }
    }
  }
  nloc = mine > 0u ? mine : 1u;
  nx = cnt > 0u ? cnt : 1u;
}
DI void xcd_barrier(const XcdBarrier& b) {
  asm volatile("s_waitcnt vmcnt(0)" ::: "memory");
  __syncthreads();
  if (threadIdx.x == 0) {
    unsigned* bar = b.bar;
    __builtin_amdgcn_s_waitcnt(0);
    unsigned nloc = b.st[0], nx = b.st[1];
    if (nloc == 0u) { xcd_barrier_complete(bar, b.x, nloc, nx); b.st[0] = nloc; b.st[1] = nx; }
    const unsigned old = xb_add(&bar[XB_XSUB(b.x)], 1u);
    const unsigned gen = old / nloc;
    if (old + 1u == (gen + 1u) * nloc) {
      __builtin_amdgcn_fence(__ATOMIC_RELEASE, "agent");
      asm volatile("s_waitcnt vmcnt(0)" ::: "memory");
      const unsigned og = xb_add(&bar[XB_TOP], 1u);
      const unsigned tg = og / nx;
      if (og + 1u == (tg + 1u) * nx) xb_add(&bar[XB_TOPGEN], 1u);
      else XB_SPIN(xb_ld(&bar[XB_TOPGEN]) == tg, bar);
      __builtin_amdgcn_fence(__ATOMIC_ACQUIRE, "agent");
      xb_add(&bar[XB_XGEN(b.x)], 1u);
      asm volatile("s_waitcnt vmcnt(0)" ::: "memory");
    } else {
      XB_SPIN(xb_ld(&bar[XB_XGEN(b.x)]) == gen, bar);
      __builtin_amdgcn_fence(__ATOMIC_ACQUIRE, "agent");
      asm volatile("s_waitcnt vmcnt(0)" ::: "memory");
    }
  }
  __syncthreads();
}

__device__ void convert_phase(const Params& p, char* smem, int tid, int bid) {
  constexpr int T_IN = 16 * 66, T_OUT = 16 * 16, PER_L = T_IN + T_OUT;
  float* tile = (float*)smem;
  const int t = tid;
  if (bid == 0 && t < 16) p.ctr[t] = 0u;
  for (int it = bid; it < DEPTH * PER_L; it += gridDim.x) {
    const int l = it / PER_L;
    int r = it % PER_L;
    const float* src; u16* dst; int N;
    if (r < T_IN) { src = p.w_in + (size_t)l * DM * INC; dst = p.wt_in + (size_t)l * INC * DM; N = INC; }
    else { r -= T_IN; src = p.w_out + (size_t)l * DM * DM; dst = p.wt_out + (size_t)l * DM * DM; N = DM; }
    const int ntn = N / 64, kt = r / ntn, nt = r % ntn;
    {
      const int c4 = (t & 15) * 4, r0 = t >> 4;
      float4 v[4];
#pragma unroll
      for (int i = 0; i < 4; ++i) v[i] = *(const float4*)(src + (size_t)(kt * 64 + r0 + 16 * i) * N + nt * 64 + c4);
#pragma unroll
      for (int i = 0; i < 4; ++i) {
        float* d = tile + (r0 + 16 * i) * 65 + c4;
        d[0] = v[i].x; d[1] = v[i].y; d[2] = v[i].z; d[3] = v[i].w;
      }
    }
    __syncthreads();
    {
      const int n = t >> 2, kc = (t & 3) * 16;
      unsigned w[8];
#pragma unroll
      for (int j = 0; j < 8; ++j) w[j] = pack_bf16(tile[(kc + 2 * j) * 65 + n], tile[(kc + 2 * j + 1) * 65 + n]);
      uint4* d = (uint4*)(dst + (size_t)(nt * 64 + n) * DM + kt * 64 + kc);
      d[0] = make_uint4(w[0], w[1], w[2], w[3]);
      d[1] = make_uint4(w[4], w[5], w[6], w[7]);
    }
    __syncthreads();
  }
}

__device__ void norm_phase(const float* __restrict__ xin, const float* __restrict__ g, u16* __restrict__ h, int tid, int bid) {
  const int lane = tid & 63;
  const int wid = bid * 4 + (tid >> 6), nw = gridDim.x * 4;
  float4 gg[4];
#pragma unroll
  for (int i = 0; i < 4; ++i) gg[i] = ((const float4*)g)[lane + 64 * i];
  float4 v[2][4], nx[2][4];
  if (wid * 2 < NTOK) {
#pragma unroll
    for (int u = 0; u < 2; ++u)
#pragma unroll
      for (int i = 0; i < 4; ++i) v[u][i] = ((const float4*)(xin + (size_t)(wid * 2 + u) * DM))[lane + 64 * i];
  }
  for (int row = wid * 2; row < NTOK; row += nw * 2) {
    if (row + nw * 2 < NTOK) {
#pragma unroll
      for (int u = 0; u < 2; ++u)
#pragma unroll
        for (int i = 0; i < 4; ++i) nx[u][i] = ((const float4*)(xin + (size_t)(row + nw * 2 + u) * DM))[lane + 64 * i];
    }
#pragma unroll
    for (int u = 0; u < 2; ++u) {
      float ss = 0.f;
#pragma unroll
      for (int i = 0; i < 4; ++i) ss += v[u][i].x * v[u][i].x + v[u][i].y * v[u][i].y + v[u][i].z * v[u][i].z + v[u][i].w * v[u][i].w;
      ss = wave_sum(ss);
      const float rs = rsqrtf(ss * (1.f / DM) + 1e-6f);
#pragma unroll
      for (int i = 0; i < 4; ++i) {
        uint2 o;
        o.x = pack_bf16(v[u][i].x * rs * gg[i].x, v[u][i].y * rs * gg[i].y);
        o.y = pack_bf16(v[u][i].z * rs * gg[i].z, v[u][i].w * rs * gg[i].w);
        *(uint2*)(h + (size_t)(row + u) * DM + (lane + 64 * i) * 4) = o;
      }
    }
#pragma unroll
    for (int u = 0; u < 2; ++u)
#pragma unroll
      for (int i = 0; i < 4; ++i) v[u][i] = nx[u][i];
  }
}

__device__ void final_norm_phase(float* __restrict__ x, const float* __restrict__ g, int tid, int bid) {
  const int lane = tid & 63;
  const int wid = bid * 4 + (tid >> 6), nw = gridDim.x * 4;
  float4 gg[4];
#pragma unroll
  for (int i = 0; i < 4; ++i) gg[i] = ((const float4*)g)[lane + 64 * i];
  float4 v[4], nx[4];
  if (wid < NTOK) {
#pragma unroll
    for (int i = 0; i < 4; ++i) v[i] = ((const float4*)(x + (size_t)wid * DM))[lane + 64 * i];
  }
  for (int row = wid; row < NTOK; row += nw) {
    float4* xr = (float4*)(x + (size_t)row * DM);
    if (row + nw < NTOK) {
#pragma unroll
      for (int i = 0; i < 4; ++i) nx[i] = ((const float4*)(x + (size_t)(row + nw) * DM))[lane + 64 * i];
    }
    float ss = 0.f;
#pragma unroll
    for (int i = 0; i < 4; ++i) ss += v[i].x * v[i].x + v[i].y * v[i].y + v[i].z * v[i].z + v[i].w * v[i].w;
    ss = wave_sum(ss);
    const float rs = rsqrtf(ss * (1.f / DM) + 1e-6f);
#pragma unroll
    for (int i = 0; i < 4; ++i) {
      float4 o;
      o.x = v[i].x * rs * gg[i].x; o.y = v[i].y * rs * gg[i].y; o.z = v[i].z * rs * gg[i].z; o.w = v[i].w * rs * gg[i].w;
      xr[lane + 64 * i] = o;
    }
#pragma unroll
    for (int i = 0; i < 4; ++i) v[i] = nx[i];
  }
}

#define LAS __attribute__((address_space(3)))
template <int MODE>
__device__ void gemm_phase(const Params& p, int l, char* smem, int tid, int bid, int nt_lo, int nt_hi, int local_skip) {
  constexpr int K = DM, BK = 32, NKT = K / BK;
  constexpr int N = MODE == 0 ? INC : DM;
  constexpr int NT = N / 128;
  constexpr int STAGE = 24576;
  const u16* __restrict__ A = MODE == 0 ? p.hbuf : p.mixed;
  const u16* __restrict__ Wt = MODE == 0 ? p.wt_in + (size_t)l * INC * DM : p.wt_out + (size_t)l * DM * DM;
  LAS char* lds = (LAS char*)smem;
  const int lane = tid & 63, w = tid >> 6, r = lane & 31, hh = lane >> 5;
  const int wm = w >> 1, wn = w & 1;
  const int sw = (r >> 2) & 3;
  const int drow = lane >> 2;
  const int dcol = ((lane & 3) ^ ((drow >> 2) & 3)) * 8;
  const int xcd = bid & 7, local = (bid >> 3) - local_skip;
  const int nlocal = ((gridDim.x - xcd + 7) >> 3) - local_skip;
  const int NTR = nt_hi - nt_lo;
  (void)NT;
  for (int j = local; j < 16 * NTR; j += nlocal) {
    const int pnl = j / (8 * NTR), rr = j % (8 * NTR);
    int nt = nt_lo + (rr >> 3);
    if (MODE == 0 && nt_lo == 0 && nt >= G1_SPLIT) nt += INC / 128 - 2 - G1_SPLIT;
    const int mt = 16 * xcd + 8 * pnl + (rr & 7);
    const int m0 = mt * 256, n0 = nt * 128;
    const int wu = __builtin_amdgcn_readfirstlane(w);
    const unsigned loff = (unsigned)(drow * K + dcol);
    const u16* gbase[6];
#pragma unroll
    for (int q = 0; q < 6; ++q) {
      const int G = wu * 6 + q;
      gbase[q] = (G < 16) ? A + (size_t)(m0 + G * 16) * K : Wt + (size_t)(n0 + (G - 16) * 16) * K;
    }
#define gsrc_(q) (gbase[q] + loff)
    f32x16 acc[4][2];
#pragma unroll
    for (int a = 0; a < 4; ++a)
#pragma unroll
      for (int b = 0; b < 2; ++b)
#pragma unroll
        for (int i = 0; i < 16; ++i) acc[a][b][i] = 0.f;
#define GEMM_DMA(stg, kt_)                                                                                   \
  do {                                                                                                       \
    _Pragma("unroll") for (int q = 0; q < 6; ++q)                                                            \
        __builtin_amdgcn_global_load_lds((const unsigned*)(gsrc_(q) + (kt_) * BK),                            \
                                         (LAS unsigned*)(lds + (stg) * STAGE + (w * 6 + q) * 1024), 16, 0, 0); \
  } while (0)
#define GEMM_FRAGS(fa_, fb_, stg, ks)                                                                        \
  do {                                                                                                       \
    const LAS char* a_s_ = lds + (stg) * STAGE;                                                              \
    const int ch_ = ((2 * (ks) + hh) ^ sw) << 4;                                                             \
    _Pragma("unroll") for (int ms = 0; ms < 4; ++ms)                                                         \
        fa_[ms] = *(const LAS bf16x8*)(a_s_ + (wm * 128 + ms * 32 + r) * 64 + ch_);                         \
    _Pragma("unroll") for (int ns = 0; ns < 2; ++ns)                                                         \
        fb_[ns] = *(const LAS bf16x8*)(a_s_ + 16384 + (wn * 64 + ns * 32 + r) * 64 + ch_);                   \
  } while (0)
#define GEMM_MMA(fa_, fb_)                                                                                   \
  do {                                                                                                       \
    __builtin_amdgcn_s_setprio(1);                                                                           \
    _Pragma("unroll") for (int ms = 0; ms < 4; ++ms)                                                         \
        _Pragma("unroll") for (int ns = 0; ns < 2; ++ns) acc[ms][ns] = MFMA32(fb_[ns], fa_[ms], acc[ms][ns]); \
    __builtin_amdgcn_s_setprio(0);                                                                           \
  } while (0)
    bf16x8 a0[4], b0[2], a1[4], b1[2];
    GEMM_DMA(0, 0);
    asm volatile("s_waitcnt vmcnt(0)" ::: "memory");
    __syncthreads();
    GEMM_DMA(1, 1);
    GEMM_FRAGS(a0, b0, 0, 0);
    for (int kt = 0; kt < NKT; ++kt) {
      const int stg = kt & 1;
      GEMM_FRAGS(a1, b1, stg, 1);
      __builtin_amdgcn_sched_barrier(0);
      GEMM_MMA(a0, b0);
      __builtin_amdgcn_sched_barrier(0);
      asm volatile("s_waitcnt vmcnt(0)" ::: "memory");
      __syncthreads();
      if (kt + 2 < NKT) GEMM_DMA(stg, kt + 2);
      if (kt + 1 < NKT) GEMM_FRAGS(a0, b0, stg ^ 1, 0);
      __builtin_amdgcn_sched_barrier(0);
      GEMM_MMA(a1, b1);
      __builtin_amdgcn_sched_barrier(0);
    }
    __syncthreads();
    if (MODE == 0) {
      char* img = smem + w * 9216;
#pragma unroll
      for (int half = 0; half < 2; ++half) {
#pragma unroll
        for (int m2 = 0; m2 < 2; ++m2)
#pragma unroll
          for (int ns = 0; ns < 2; ++ns)
#pragma unroll
            for (int g = 0; g < 4; ++g) {
              uint2 v;
              v.x = pack_bf16(acc[2 * half + m2][ns][4 * g + 0], acc[2 * half + m2][ns][4 * g + 1]);
              v.y = pack_bf16(acc[2 * half + m2][ns][4 * g + 2], acc[2 * half + m2][ns][4 * g + 3]);
              *(uint2*)(img + (m2 * 32 + r) * 144 + (ns * 32 + 8 * g + 4 * hh) * 2) = v;
            }
        asm volatile("s_waitcnt lgkmcnt(0)" ::: "memory");
        const int tb = m0 + wm * 128 + half * 64;
        if (n0 >= 1024 && n0 < 1536) {
          const u16* im = (const u16*)img;
          const int bb = tb >> 12, sq = tb & 4095;
          const int c = lane & 7;
#pragma unroll
          for (int jj = 0; jj < 8; ++jj) {
            const int n = (lane >> 3) + 8 * jj;
            const int dv = n0 - 1024 + wn * 64 + n;
            unsigned e[8];
#pragma unroll
            for (int q = 0; q < 8; ++q)
              e[q] = im[(16 * (c >> 1) + 4 * (c & 1) + (q & 3) + 8 * (q >> 2)) * 72 + n];
            u32x4 v;
            v.x = e[0] | (e[1] << 16); v.y = e[2] | (e[3] << 16); v.z = e[4] | (e[5] << 16); v.w = e[6] | (e[7] << 16);
            *(u32x4*)(p.vT + ((size_t)((bb * 4 + (dv >> 7)) * 128 + (dv & 127))) * SEQ + sq + 8 * c) = v;
          }
        } else {
          const int colb = (n0 < 1024 ? n0 : n0 - 512) + wn * 64 + (lane & 7) * 8;
#pragma unroll
          for (int jj = 0; jj < 8; ++jj) {
            const int row = (lane >> 3) + 8 * jj;
            const u32x4 v = *(const u32x4*)(img + row * 144 + (lane & 7) * 16);
            *(u32x4*)(p.pbuf + (size_t)(tb + row) * PS + colb) = v;
          }
        }
        if (half == 1) __syncthreads(); else asm volatile("s_waitcnt lgkmcnt(0)" ::: "memory");
      }
    } else {
      const float* xold = (l == 0) ? p.x : p.out;
      float* img = (float*)(smem + w * 8704);
      const size_t idx0 = (size_t)(m0 + wm * 128 + (lane >> 4)) * DM + n0 + wn * 64 + (lane & 15) * 4;
      float4 xc[8], xn[8];
#pragma unroll
      for (int jj = 0; jj < 8; ++jj) xc[jj] = *(const float4*)(xold + idx0 + (size_t)(4 * jj) * DM);
#pragma unroll
      for (int ms = 0; ms < 4; ++ms) {
        if (ms < 3) {
#pragma unroll
          for (int jj = 0; jj < 8; ++jj) xn[jj] = *(const float4*)(xold + idx0 + (size_t)((ms + 1) * 32 + 4 * jj) * DM);
        }
#pragma unroll
        for (int ns = 0; ns < 2; ++ns)
#pragma unroll
          for (int g = 0; g < 4; ++g)
            *(float4*)(img + r * 68 + ns * 32 + 8 * g + 4 * hh) =
                make_float4(acc[ms][ns][4 * g + 0], acc[ms][ns][4 * g + 1], acc[ms][ns][4 * g + 2], acc[ms][ns][4 * g + 3]);
        asm volatile("s_waitcnt lgkmcnt(0)" ::: "memory");
#pragma unroll
        for (int jj = 0; jj < 8; ++jj) {
          const int row = (lane >> 4) + 4 * jj, chunk = lane & 15;
          const float4 a4 = *(const float4*)(img + row * 68 + chunk * 4);
          float4 x = xc[jj];
          x.x += a4.x; x.y += a4.y; x.z += a4.z; x.w += a4.w;
          *(float4*)(p.out + idx0 + (size_t)(ms * 32 + 4 * jj) * DM) = x;
        }
        if (ms == 3) __syncthreads(); else asm volatile("s_waitcnt lgkmcnt(0)" ::: "memory");
#pragma unroll
        for (int jj = 0; jj < 8; ++jj) xc[jj] = xn[jj];
      }
    }
  }
}

struct PrepRaw { u16 r, k, v, l, cb, cc, ch, z; };
DI void prep_load(PrepRaw& n, const u16* q, int c, int lcol) {
  n.r = q[PC_RW + c]; n.k = q[PC_RW + 256 + c]; n.v = q[PC_RW + 512 + c]; n.l = q[lcol];
  n.cb = q[PC_CB + c]; n.cc = q[PC_CC + c]; n.ch = q[PC_CH + c]; n.z = q[PC_ZCONV + c];
}
using f32x4v = __attribute__((ext_vector_type(4))) float;
#define MFMA16(a, b, c) __builtin_amdgcn_mfma_f32_16x16x32_bf16((a), (b), (c), 0, 0, 0)
__device__ void prep_phase(const Params& p, int l, char* smem, int tid, int bid) {
  u16* Xs = (u16*)smem;
  float* DWs = (float*)(smem + 8192);
  float* DAs = (float*)(smem + 24832);
  const int c = tid, lane = c & 63, hd = c >> 6;
  const int quad = lane >> 4, l15 = lane & 15;
  bf16x8 wf[4][2], af[4][2];
  {
    const float* wu = p.w_up + (size_t)l * 64 * 256;
    const float* au = p.a_up + (size_t)l * 64 * 256;
#pragma unroll
    for (int nt = 0; nt < 4; ++nt)
#pragma unroll
      for (int ks = 0; ks < 2; ++ks) {
        const int ch = 64 * hd + 16 * nt + l15, k0 = ks * 32 + quad * 8;
        u32x4 tw, ta;
        tw.x = pack_bf16(wu[(k0 + 0) * 256 + ch], wu[(k0 + 1) * 256 + ch]);
        tw.y = pack_bf16(wu[(k0 + 2) * 256 + ch], wu[(k0 + 3) * 256 + ch]);
        tw.z = pack_bf16(wu[(k0 + 4) * 256 + ch], wu[(k0 + 5) * 256 + ch]);
        tw.w = pack_bf16(wu[(k0 + 6) * 256 + ch], wu[(k0 + 7) * 256 + ch]);
        ta.x = pack_bf16(au[(k0 + 0) * 256 + ch], au[(k0 + 1) * 256 + ch]);
        ta.y = pack_bf16(au[(k0 + 2) * 256 + ch], au[(k0 + 3) * 256 + ch]);
        ta.z = pack_bf16(au[(k0 + 4) * 256 + ch], au[(k0 + 5) * 256 + ch]);
        ta.w = pack_bf16(au[(k0 + 6) * 256 + ch], au[(k0 + 7) * 256 + ch]);
        wf[nt][ks] = __builtin_bit_cast(bf16x8, tw);
        af[nt][ks] = __builtin_bit_cast(bf16x8, ta);
      }
  }
  const float* mu = p.mu + l * 896;
  const float mu_r = mu[c], mu_k = mu[256 + c], mu_v = mu[512 + c];
  const int xcol = c & 127, xhalf = c >> 7;
  const float mu_l = mu[768 + xcol];
  const float w0c = p.w0[l * 256 + c], a0c = p.a0[l * 256 + c], kkc = p.k_k[l * 256 + c], kac = p.k_a[l * 256 + c],
              rkc = p.r_k[l * 256 + c];
  const float cw0 = p.conv_w[l * 768 + c], cw1 = p.conv_w[l * 768 + 256 + c], cw2 = p.conv_w[l * 768 + 512 + c];
  for (int tile = bid; tile < NTOK / 64; tile += gridDim.x) {
    const int tok0 = tile * 64;
    const int b = tok0 >> 12, s0 = tok0 & 4095;
    float pr = 0.f, pk = 0.f, pv = 0.f, u1 = 0.f, u2 = 0.f;
    if (s0 > 0) {
      const u16* q = p.pbuf + (size_t)(tok0 - 1) * PS;
      pr = bf2f(q[PC_RW + c]); pk = bf2f(q[PC_RW + 256 + c]); pv = bf2f(q[PC_RW + 512 + c]);
      u1 = bf2f(q[PC_CC + c]) * bf2f(q[PC_CH + c]);
      const u16* q2 = q - PS;
      u2 = bf2f(q2[PC_CC + c]) * bf2f(q2[PC_CH + c]);
    }
    u16 raw[9], rawn[9];
    {
      const int tb = tok0 + 8 * xhalf;
      const u16* q = p.pbuf + (size_t)tb * PS + PC_RW + 768 + xcol;
      raw[0] = ((tb & 4095) > 0) ? *(q - PS) : (u16)0;
#pragma unroll
      for (int e = 0; e < 8; ++e) raw[e + 1] = q[(size_t)e * PS];
    }
    PrepRaw cur4[4], nxt4[4];
#pragma unroll
    for (int i4 = 0; i4 < 4; ++i4) prep_load(cur4[i4], p.pbuf + (size_t)(tok0 + i4) * PS, c, PC_RW + c);
    for (int st = 0; st < 4; ++st) {
      const int T0 = tok0 + 16 * st;
      {
        if (st < 3) {
          const int tb = T0 + 16 + 8 * xhalf;
          const u16* q = p.pbuf + (size_t)tb * PS + PC_RW + 768 + xcol;
          rawn[0] = *(q - PS);
#pragma unroll
          for (int e = 0; e < 8; ++e) rawn[e + 1] = q[(size_t)e * PS];
        }
#pragma unroll
        for (int e = 0; e < 8; ++e) {
          const float cur = bf2f(raw[e + 1]), prv = bf2f(raw[e]);
          const float xl = cur + (prv - cur) * mu_l;
          const float val = (xcol < 64) ? (1.f - 2.f / (1.f + __expf(2.f * xl))) : xl;
          Xs[(8 * xhalf + e) * 136 + xcol] = to_bf16(val);
        }
#pragma unroll
        for (int e = 0; e < 9; ++e) raw[e] = rawn[e];
      }
      __syncthreads();
      {
        bf16x8 xa[4];
#pragma unroll
        for (int k4 = 0; k4 < 4; ++k4) xa[k4] = *(const bf16x8*)(Xs + l15 * 136 + k4 * 32 + quad * 8);
#pragma unroll
        for (int nt = 0; nt < 4; ++nt) {
          f32x4v dw = {0.f, 0.f, 0.f, 0.f}, da = {0.f, 0.f, 0.f, 0.f};
          dw = MFMA16(xa[0], wf[nt][0], dw);
          dw = MFMA16(xa[1], wf[nt][1], dw);
          da = MFMA16(xa[2], af[nt][0], da);
          da = MFMA16(xa[3], af[nt][1], da);
          const int ch = 64 * hd + 16 * nt + l15;
#pragma unroll
          for (int j = 0; j < 4; ++j) {
            DWs[(quad * 4 + j) * 260 + ch] = dw[j];
            DAs[(quad * 4 + j) * 260 + ch] = da[j];
          }
        }
      }
      __syncthreads();
      u16* SB = (u16*)(smem + 41472);
      float* SF = (float*)(smem + 41472 + 8192);
      u16* SCV = (u16*)(smem + 41472 + 16384);
      float* SSC = (float*)(smem + 41472 + 18432);
      for (int g = 0; g < 4; ++g) {
        if (g < 3 || st < 3) {
#pragma unroll
          for (int i4 = 0; i4 < 4; ++i4) prep_load(nxt4[i4], p.pbuf + (size_t)(T0 + 4 * g + 4 + i4) * PS, c, PC_RW + c);
        }
#pragma unroll
        for (int i4 = 0; i4 < 4; ++i4) {
          const int i = g * 4 + i4;
          const int tok = T0 + i;
          const PrepRaw nx = cur4[i4];
          const float cr = bf2f(nx.r), ck = bf2f(nx.k), cv = bf2f(nx.v);
          const float ccb = bf2f(nx.cb), ccc = bf2f(nx.cc), cch = bf2f(nx.ch), cz = bf2f(nx.z);
          {
            const float uu = ccc * cch;
            const float y = cw0 * u2 + cw1 * u1 + cw2 * uu;
            u2 = u1; u1 = uu;
            SCV[i4 * 256 + c] = to_bf16(ccb * y * silu(cz));
          }
          const float xr = cr + (pr - cr) * mu_r, xk = ck + (pk - ck) * mu_k, xv = cv + (pv - cv) * mu_v;
          pr = cr; pk = ck; pv = cv;
          const float dws = DWs[i * 260 + c], das = DAs[i * 260 + c];
          const float wz = -(w0c + dws);
          const float sp = (wz > 20.f) ? wz : __logf(1.f + __expf(wz));
          const float decay = __expf(-__expf(-sp - 0.5f));
          const float a = 1.f / (1.f + __expf(-(a0c + das)));
          const float kkv = xk * kkc;
          const float ssq = wave_sum(kkv * kkv);
          const float kk = kkv / fmaxf(sqrtf(ssq), 1e-12f);
          const float kmod = xk * (1.f + (a - 1.f) * kac);
          const float bb = kk * a;
          const float wr = decay * xr;
          const float br = wave_sum(bb * xr);
          const float kr = wave_sum(kmod * xr);
          const float rkr = wave_sum(xr * kmod * rkc);
          SB[(0 * 4 + i4) * 256 + c] = to_bf16(kk);
          SB[(1 * 4 + i4) * 256 + c] = to_bf16(bb);
          SB[(2 * 4 + i4) * 256 + c] = to_bf16(kmod);
          SB[(3 * 4 + i4) * 256 + c] = to_bf16(wr);
          SF[(0 * 4 + i4) * 256 + c] = decay;
          SF[(1 * 4 + i4) * 256 + c] = xv;
          if (lane == 0) {
            *(float4*)(SSC + (i4 * 4 + hd) * 8) = make_float4(br, kr, rkr, 0.f);
          }
        }
        __syncthreads();
        {
          const int tg = s0 + 16 * st + 4 * g;
          {
            const int sel = tid >> 7, q = tid & 127, pr_ = q >> 3, part = q & 7;
            const int tk = pr_ >> 2, hq = pr_ & 3;
            const size_t rec = (size_t)(b * 4 + hq) * SEQ + tg + tk;
            const u32x4 v0 = *(const u32x4*)(SB + ((2 * sel) * 4 + tk) * 256 + hq * 64 + part * 8);
            const u32x4 v1 = *(const u32x4*)(SB + ((2 * sel + 1) * 4 + tk) * 256 + hq * 64 + part * 8);
            u16* d0 = sel ? p.s_kx : p.s_kk;
            u16* d1 = sel ? p.s_wr : p.s_bb;
            *(u32x4*)(d0 + rec * 64 + part * 8) = v0;
            *(u32x4*)(d1 + rec * 64 + part * 8) = v1;
          }
          {
            const int pr_ = tid >> 4, part = tid & 15;
            const int tk = pr_ >> 2, hq = pr_ & 3;
            const size_t rec = (size_t)(b * 4 + hq) * SEQ + tg + tk;
            *(u32x4*)(p.s_w + rec * 64 + part * 4) = *(const u32x4*)(SF + (0 * 4 + tk) * 256 + hq * 64 + part * 4);
            *(u32x4*)(p.s_v + rec * 64 + part * 4) = *(const u32x4*)(SF + (1 * 4 + tk) * 256 + hq * 64 + part * 4);
          }
          if (tid < 128) {
            const int tk = tid >> 5, part = tid & 31;
            *(u32x4*)(p.pbuf + (size_t)(T0 + 4 * g + tk) * PS + PC_CB + part * 8) = *(const u32x4*)(SCV + tk * 256 + part * 8);
          } else if (tid < 144) {
            const int pr_ = tid - 128;
            const int tk = pr_ >> 2, hq = pr_ & 3;
            const size_t rec = (size_t)(b * 4 + hq) * SEQ + tg + tk;
            *(float4*)(p.s_sc + rec * 4) = *(const float4*)(SSC + pr_ * 8);
          }
        }
        __syncthreads();
#pragma unroll
        for (int i4 = 0; i4 < 4; ++i4) cur4[i4] = nxt4[i4];
      }
    }
    __syncthreads();
  }
}

DI float dpp_xor1(float v) {
  return __builtin_bit_cast(float, __builtin_amdgcn_update_dpp(0, __builtin_bit_cast(int, v), 0xB1, 0xF, 0xF, true));
}
DI float dpp_xor2(float v) {
  return __builtin_bit_cast(float, __builtin_amdgcn_update_dpp(0, __builtin_bit_cast(int, v), 0x4E, 0xF, 0xF, true));
}
constexpr int SC_STEP = 340, SC_TC = 16, SC_BUF = SC_STEP * SC_TC;
struct ScanRegs { u32x4 a, b, w, v; float4 sc; };

DI void scan_load(const Params& p, int bh, int quarter, int chunk, int tid, ScanRegs& R) {
  const size_t base = ((size_t)bh * SEQ + chunk * SC_TC) * 64;
  const int c = tid & 127;
  const u16* pa = (tid < 128) ? p.s_kk : p.s_bb;
  const u16* pb = (tid < 128) ? p.s_kx : p.s_wr;
  R.a = *(const u32x4*)(pa + base + c * 8);
  R.b = *(const u32x4*)(pb + base + c * 8);
  R.w = *(const u32x4*)(p.s_w + base + tid * 4);
  if (tid < 64) {
    const int st = tid >> 2, q = tid & 3;
    R.v = *(const u32x4*)(p.s_v + base + st * 64 + quarter * 16 + q * 4);
  } else if (tid >= 128 && tid < 144) {
    R.sc = *(const float4*)(p.s_sc + ((size_t)bh * SEQ + chunk * SC_TC + (tid - 128)) * 4);
  }
}
DI void scan_cvt_store(float* d, u32x4 u) {
  *(float4*)(d) = make_float4(bf_lo(u.x), bf_hi(u.x), bf_lo(u.y), bf_hi(u.y));
  *(float4*)(d + 4) = make_float4(bf_lo(u.z), bf_hi(u.z), bf_lo(u.w), bf_hi(u.w));
}
DI void scan_store(float* buf, int tid, const ScanRegs& R) {
  {
    const int c = tid & 127, st = c >> 3, q = c & 7;
    float* d = buf + st * SC_STEP + q * 8;
    scan_cvt_store(d + (tid < 128 ? 0 : 64), R.a);
    scan_cvt_store(d + (tid < 128 ? 192 : 256), R.b);
  }
  {
    const int e = tid * 4;
    *(u32x4*)(buf + (e >> 6) * SC_STEP + 128 + (e & 63)) = R.w;
  }
  if (tid < 64) {
    const int st = tid >> 2, q = tid & 3;
    *(u32x4*)(buf + st * SC_STEP + 320 + q * 4) = R.v;
  } else if (tid >= 128 && tid < 144) {
    *(float4*)(buf + (tid - 128) * SC_STEP + 336) = R.sc;
  }
}

struct StepOps { f2_t kk[2], bb[2], ww[2], kx[2], wr[2]; float vv; f2_t bk; };
DI void step_load(StepOps& o, const float* sb, int kq, int row) {
  const f2_t* q = (const f2_t*)(sb + kq * 4);
#pragma unroll
  for (int j = 0; j < 2; ++j) {
    o.kk[j] = q[j];
    o.bb[j] = q[32 + j];
    o.ww[j] = q[64 + j];
    o.kx[j] = q[96 + j];
    o.wr[j] = q[128 + j];
  }
  o.vv = sb[320 + row];
  o.bk = *(const f2_t*)(sb + 336);
}
template <int CTRL>
DI float dpp_mov(float v) {
  return __builtin_bit_cast(float, __builtin_amdgcn_update_dpp(0, __builtin_bit_cast(int, v), CTRL, 0xF, 0xF, true));
}
DI void step_compute(f2_t (&S)[2], const StepOps& o, float& ykeep, bool keep) {
  f2_t sa2 = S[0] * o.kk[0], yd2 = S[0] * o.wr[0];
  sa2 += S[1] * o.kk[1];
  yd2 += S[1] * o.wr[1];
  float sa = sa2.x + sa2.y, yd = yd2.x + yd2.y;
  sa += dpp_mov<0xB1>(sa); yd += dpp_mov<0xB1>(yd);
  sa += dpp_mov<0x4E>(sa); yd += dpp_mov<0x4E>(yd);
  sa += dpp_mov<0x124>(sa); yd += dpp_mov<0x124>(yd);
  sa += dpp_mov<0x128>(sa); yd += dpp_mov<0x128>(yd);
  const f2_t vv2 = {o.vv, o.vv}, sa2b = {sa, sa};
#pragma unroll
  for (int j = 0; j < 2; ++j) {
    f2_t t = vv2 * o.kx[j];
    t = t - sa2b * o.bb[j];
    S[j] = S[j] * o.ww[j] + t;
  }
  const float y = yd - sa * o.bk.x + o.vv * o.bk.y;
  ykeep = keep ? y : ykeep;
}

__device__ void scan_item(const Params& p, int item, char* smem, int tid, int ch0, int ch1) {
  float* lds = (float*)smem;
  const int bh = item >> 2, quarter = item & 3;
  const int w = tid >> 6, lane = tid & 63;
  const int NCH = SEQ / SC_TC;
  ScanRegs R;
  f2_t S[2];
  float4* const stp = (float4*)(p.s_state) + (size_t)item * 256 + tid;
  if (ch0 == 0) {
    S[0] = f2_t{0.f, 0.f};
    S[1] = f2_t{0.f, 0.f};
  } else {
    const float4 sv = *stp;
    S[0] = f2_t{sv.x, sv.y};
    S[1] = f2_t{sv.z, sv.w};
  }
  const int row = (lane >> 4) + 4 * w;
  const int kq = lane & 15;
  __syncthreads();
  (void)NCH;
  scan_load(p, bh, quarter, ch0, tid, R);
  scan_store(lds + (ch0 & 1) * SC_BUF, tid, R);
  scan_load(p, bh, quarter, ch0 + 1, tid, R);
  __syncthreads();
  for (int ch = ch0; ch < ch1; ++ch) {
    const float* buf = lds + (ch & 1) * SC_BUF;
    if (ch + 1 < ch1) scan_store(lds + ((ch + 1) & 1) * SC_BUF, tid, R);
    if (ch + 2 < ch1) scan_load(p, bh, quarter, ch + 2, tid, R);
    float ykeep = 0.f;
    StepOps o0, o1;
    step_load(o0, buf, kq, row);
#pragma unroll
    for (int st = 0; st < SC_TC; st += 2) {
      step_load(o1, buf + (st + 1) * SC_STEP, kq, row);
      step_compute(S, o0, ykeep, kq == st);
      if (st + 2 < SC_TC) step_load(o0, buf + (st + 2) * SC_STEP, kq, row);
      step_compute(S, o1, ykeep, kq == st + 1);
    }
    p.s_v[((size_t)bh * SEQ + ch * SC_TC + kq) * 64 + quarter * 16 + row] = ykeep;
    __syncthreads();
  }
  if (ch1 < SEQ / SC_TC) *stp = make_float4(S[0].x, S[0].y, S[1].x, S[1].y);
}

DI void vstore(char* lo, char* hi, u32x4 a, u32x4 b, u32x4 c, u32x4 d) {
  *(uint2*)(lo) = make_uint2(a.x, a.y); *(uint2*)(hi) = make_uint2(a.z, a.w);
  *(uint2*)(lo + 4096) = make_uint2(b.x, b.y); *(uint2*)(hi + 4096) = make_uint2(b.z, b.w);
  *(uint2*)(lo + 8192) = make_uint2(c.x, c.y); *(uint2*)(hi + 8192) = make_uint2(c.z, c.w);
  *(uint2*)(lo + 12288) = make_uint2(d.x, d.y); *(uint2*)(hi + 12288) = make_uint2(d.z, d.w);
}
__device__ void attn_item(const Params& p, int l, int a, float lam, float one_minus_li, char* smem, int tid) {
  const int qb = 31 - (a >> 5), bhx = a & 31, b = bhx >> 2, h = bhx & 3;
  const int t = tid, lane = t & 63, w = t >> 6, r = lane & 31, hh = lane >> 5;
  const int sw = (r >> 1) & 7;
  const int q0 = qb * 128;
  const int qpos = q0 + w * 32 + r;
  const size_t tokq = (size_t)b * SEQ + qpos;
  float* lut = (float*)(smem + 49152);
  const float LOG2E = 1.4426950408889634f;
  __syncthreads();
  {
    const int d = t - 128;
    float v = -1e30f;
    if (d >= 0) {
      int bk;
      if (d < 16) bk = d;
      else {
        bk = 16 + (int)(logf((float)d / 16.f) / logf(8.f) * 16.f);
        bk = bk > 31 ? 31 : bk;
      }
      v = p.rel_bias[bk * 4 + h] * LOG2E;
    }
    lut[t] = v;
  }
  const float cbias = p.rel_bias[31 * 4 + h] * LOG2E;
  const int dq = qpos - 4 * hh;
  const float sc = 0.125f * LOG2E;
  const int ntiles = 2 * (qb + 1);
  const int lc = t & 7, lr = t >> 3;
  const unsigned ldsw = lr * 128 + ((lc ^ ((lr >> 1) & 7)) << 4);
  const int drl = lane >> 3, dpc = lane & 7;
  const int dc0 = (dpc ^ (drl >> 1)) * 8;
  const int dc1 = (dpc ^ (4 + (drl >> 1))) * 8;
  const u16* vsrc0 = p.vT + ((size_t)((b * 4 + h) * 128 + w * 32 + drl)) * SEQ;
  LAS char* ldsl = (LAS char*)smem;
  (void)lc; (void)lr; (void)ldsw;
#pragma unroll
  for (int m = 0; m < 2; ++m) {
    const u16* ksrc0 = p.pbuf + ((size_t)b * SEQ + w * 16 + drl) * PS + PC_K + h * 128 + m * 64;
    bf16x8 qf[4];
    {
      const u16* qp = p.pbuf + tokq * PS + PC_Q + h * 128 + m * 64 + hh * 8;
#pragma unroll
      for (int ks = 0; ks < 4; ++ks) qf[ks] = *(const bf16x8*)(qp + ks * 16);
    }
    f32x16 O[4];
#pragma unroll
    for (int d = 0; d < 4; ++d)
#pragma unroll
      for (int i = 0; i < 16; ++i) O[d][i] = 0.f;
    float m_i = -1e30f, l_i = 0.f;
    __syncthreads();
#define ATT_STAGE(buf, kk0)                                                                                             \
  do {                                                                                                                  \
    __builtin_amdgcn_global_load_lds((const unsigned*)(ksrc0 + (size_t)(kk0) * PS + dc0),                               \
                                     (LAS unsigned*)(ldsl + (buf) * 8192 + (w * 2) * 1024), 16, 0, 0);                  \
    __builtin_amdgcn_global_load_lds((const unsigned*)(ksrc0 + (size_t)((kk0) + 8) * PS + dc1),                         \
                                     (LAS unsigned*)(ldsl + (buf) * 8192 + (w * 2 + 1) * 1024), 16, 0, 0);              \
    _Pragma("unroll") for (int q_ = 0; q_ < 4; ++q_)                                                                   \
        __builtin_amdgcn_global_load_lds((const unsigned*)(vsrc0 + (size_t)(q_ * 8) * SEQ + (kk0) + ((q_ & 1) ? dc1 : dc0)), \
                                         (LAS unsigned*)(ldsl + 16384 + (buf) * 16384 + (w * 4 + q_) * 1024), 16, 0, 0); \
  } while (0)
    ATT_STAGE(0, 0);
    asm volatile("s_waitcnt vmcnt(0)" ::: "memory");
    __syncthreads();
    for (int kt = 0; kt < ntiles; ++kt) {
      const int k0 = kt * 64;
      if (kt + 1 < ntiles) ATT_STAGE((kt + 1) & 1, k0 + 64);
      const char* k_s = smem + (kt & 1) * 8192;
      const char* v_s = smem + 16384 + (kt & 1) * 16384;
      f32x16 sacc[2];
#pragma unroll
      for (int sub = 0; sub < 2; ++sub) {
#pragma unroll
        for (int i = 0; i < 16; ++i) sacc[sub][i] = 0.f;
#pragma unroll
        for (int ks = 0; ks < 4; ++ks) {
          const bf16x8 kf = *(const bf16x8*)(k_s + (sub * 32 + r) * 128 + (((2 * ks + hh) ^ sw) << 4));
          sacc[sub] = MFMA32(kf, qf[ks], sacc[sub]);
        }
      }
      float rs = 0.f, alpha;
      if (kt + 4 >= ntiles) {
        float mx = -1e30f;
#pragma unroll
        for (int sub = 0; sub < 2; ++sub)
#pragma unroll
          for (int i = 0; i < 16; ++i) {
            const int d = dq - k0 - (sub * 32 + (i & 3) + 8 * (i >> 2));
            const int di = d < -128 ? -128 : (d > 127 ? 127 : d);
            const float sv = sacc[sub][i] * sc + lut[di + 128];
            sacc[sub][i] = sv;
            mx = fmaxf(mx, sv);
          }
        mx = fmaxf(mx, __shfl_xor(mx, 32, 64));
        const float m_new = fmaxf(m_i, mx);
        alpha = __builtin_amdgcn_exp2f(m_i - m_new);
        m_i = m_new;
#pragma unroll
        for (int sub = 0; sub < 2; ++sub)
#pragma unroll
          for (int i = 0; i < 16; ++i) {
            const float pe = __builtin_amdgcn_exp2f(sacc[sub][i] - m_new);
            sacc[sub][i] = pe;
            rs += pe;
          }
      } else {
        float mx = -1e30f;
#pragma unroll
        for (int sub = 0; sub < 2; ++sub)
#pragma unroll
          for (int i = 0; i < 16; ++i) mx = fmaxf(mx, sacc[sub][i]);
        mx = fmaxf(mx, __shfl_xor(mx, 32, 64));
        const float m_new = fmaxf(m_i, mx * sc + cbias);
        alpha = __builtin_amdgcn_exp2f(m_i - m_new);
        m_i = m_new;
        const float off = cbias - m_new;
#pragma unroll
        for (int sub = 0; sub < 2; ++sub)
#pragma unroll
          for (int i = 0; i < 16; ++i) {
            const float pe = __builtin_amdgcn_exp2f(sacc[sub][i] * sc + off);
            sacc[sub][i] = pe;
            rs += pe;
          }
      }
      l_i = l_i * alpha + rs;
      if (__any(alpha != 1.f)) {
#pragma unroll
        for (int d = 0; d < 4; ++d)
#pragma unroll
          for (int i = 0; i < 16; ++i) O[d][i] *= alpha;
      }
#pragma unroll
      for (int kst = 0; kst < 4; ++kst) {
        const int sub = kst >> 1, s2 = kst & 1;
        uint4 pk;
        pk.x = pack_bf16(sacc[sub][8 * s2 + 0], sacc[sub][8 * s2 + 1]);
        pk.y = pack_bf16(sacc[sub][8 * s2 + 2], sacc[sub][8 * s2 + 3]);
        pk.z = pack_bf16(sacc[sub][8 * s2 + 4], sacc[sub][8 * s2 + 5]);
        pk.w = pack_bf16(sacc[sub][8 * s2 + 6], sacc[sub][8 * s2 + 7]);
        const bf16x8 pf = __builtin_bit_cast(bf16x8, pk);
#pragma unroll
        for (int d = 0; d < 4; ++d) {
          const bf16x8 vf = *(const bf16x8*)(v_s + (d * 32 + r) * 128 + (((2 * kst + hh) ^ sw) << 4));
          O[d] = MFMA32(vf, pf, O[d]);
        }
      }
      asm volatile("s_waitcnt vmcnt(0)" ::: "memory");
      __syncthreads();
    }
    const float lt = l_i + __shfl_xor(l_i, 32, 64);
    const float inv = 1.f / lt;
    if (m == 0) {
      u16* orow0 = p.mixed + tokq * DM + h * 128;
#pragma unroll
      for (int d = 0; d < 4; ++d)
#pragma unroll
        for (int g = 0; g < 4; ++g) {
          uint2 ov;
          ov.x = pack_bf16(O[d][4 * g + 0] * inv, O[d][4 * g + 1] * inv);
          ov.y = pack_bf16(O[d][4 * g + 2] * inv, O[d][4 * g + 3] * inv);
          *(uint2*)(orow0 + d * 32 + 8 * g + 4 * hh) = ov;
        }
    } else {
      const float li = lam * inv;
      const u16* orow0 = p.mixed + tokq * DM + h * 128;
#pragma unroll
      for (int d = 0; d < 4; ++d)
#pragma unroll
        for (int g = 0; g < 4; ++g) {
          const uint2 ov = *(const uint2*)(orow0 + d * 32 + 8 * g + 4 * hh);
          O[d][4 * g + 0] = bf_lo(ov.x) - O[d][4 * g + 0] * li;
          O[d][4 * g + 1] = bf_hi(ov.x) - O[d][4 * g + 1] * li;
          O[d][4 * g + 2] = bf_lo(ov.y) - O[d][4 * g + 2] * li;
          O[d][4 * g + 3] = bf_hi(ov.y) - O[d][4 * g + 3] * li;
        }
      float ss = 0.f;
#pragma unroll
      for (int d = 0; d < 4; ++d)
#pragma unroll
        for (int i = 0; i < 16; ++i) ss += O[d][i] * O[d][i];
      ss += __shfl_xor(ss, 32, 64);
      const float rms = rsqrtf(ss * (1.f / 128.f) + 1e-5f) * one_minus_li;
      const float* sg = p.subln_g + l * 128;
      const u16* zrow = p.pbuf + tokq * PS + PC_ZATT + h * 128;
      u16* orow = p.mixed + tokq * DM + h * 128;
#pragma unroll
      for (int d = 0; d < 4; ++d)
#pragma unroll
        for (int g = 0; g < 4; ++g) {
          const int dv = d * 32 + 8 * g + 4 * hh;
          const uint2 zz = *(const uint2*)(zrow + dv);
          const float4 gg = *(const float4*)(sg + dv);
          const float o0 = O[d][4 * g + 0] * rms * gg.x * silu(bf_lo(zz.x));
          const float o1 = O[d][4 * g + 1] * rms * gg.y * silu(bf_hi(zz.x));
          const float o2 = O[d][4 * g + 2] * rms * gg.z * silu(bf_lo(zz.y));
          const float o3 = O[d][4 * g + 3] * rms * gg.w * silu(bf_hi(zz.y));
          uint2 ov;
          ov.x = pack_bf16(o0, o1);
          ov.y = pack_bf16(o2, o3);
          *(uint2*)(orow + dv) = ov;
        }
    }
  }
}

__device__ void mix1_phase(const Params& p, int l, char* smem, int tid, int bid) {
  if (bid < N_SCAN_ITEMS) scan_item(p, bid, smem, tid, 0, SCAN_T1 / SC_TC);
  else gemm_phase<0>(p, l, smem, tid, bid, 0, G1_SPLIT + 2, N_SCAN_ITEMS / 8);
}
__device__ void mix2_phase(const Params& p, int lc, char* smem, int tid, int bid) {
  const int l = lc & 3;
  unsigned* slot = (unsigned*)(smem + 65536);
  if (bid < N_SCAN_ITEMS) {
#ifdef PROBE_ATT_ONLY
    if (lc < 4)
#endif
    scan_item(p, bid, smem, tid, SCAN_T1 / SC_TC, SEQ / SC_TC);
    asm volatile("" : "+v"(tid));
  }
  const int lane = tid & 63;
  const float* lq = p.lam_qk + l * 256;
  const float d1 = wave_sum(lq[lane] * lq[64 + lane]);
  const float d2 = wave_sum(lq[128 + lane] * lq[192 + lane]);
  const float lambda_init = 0.8f - 0.6f * expf(-0.3f * (float)l);
  const float lam = expf(d1) - expf(d2) + lambda_init;
  for (;;) {
    __syncthreads();
    if (tid == 0) slot[0] = atomicAdd(&p.ctr[lc], 1u);
    __syncthreads();
    const unsigned it = slot[0];
    if (it >= (unsigned)N_ATT_ITEMS) break;
#ifdef PROBE_SCAN_ONLY
    if (lc >= 4) break;
#endif
    asm volatile("" : "+v"(tid));
    attn_item(p, l, (int)it, lam, 1.f - lambda_init, smem, tid);
  }
}

struct FinRaw { float y[8]; float rkr[8]; u16 pv[9]; u16 z[8]; u16 cvo[8]; };
DI void fin_load(const Params& p, FinRaw& f, int tb, int c, int lane, int hd) {
  const int tok0 = tb * 8;
  const int b = tok0 >> 12, s0 = tok0 & 4095;
  f.pv[0] = (s0 > 0) ? p.pbuf[(size_t)(tok0 - 1) * PS + PC_RW + 512 + c] : (u16)0;
#pragma unroll
  for (int i = 0; i < 8; ++i) {
    const size_t rec = (size_t)(b * 4 + hd) * SEQ + s0 + i;
    f.y[i] = p.s_v[rec * 64 + lane];
    f.rkr[i] = p.s_sc[rec * 4 + 2];
    f.pv[i + 1] = p.pbuf[(size_t)(tok0 + i) * PS + PC_RW + 512 + c];
    f.z[i] = p.pbuf[(size_t)(tok0 + i) * PS + PC_ZRW + c];
    f.cvo[i] = p.pbuf[(size_t)(tok0 + i) * PS + PC_CB + c];
  }
}
__device__ void rwkv_final_phase(const Params& p, int l, char* smem, int tid, int bid) {
  u16* stg = (u16*)smem;
  const int c = tid, lane = c & 63, hd = c >> 6;
  const float g = p.lnx_g[l * 256 + c], bta = p.lnx_b[l * 256 + c];
  const float mu_v = p.mu[l * 896 + 512 + c];
  constexpr int TB = 8;
  const int ngrp = NTOK / TB;
  FinRaw cur, nxt;
  if (bid < ngrp) fin_load(p, cur, bid, c, lane, hd);
  for (int tb = bid; tb < ngrp; tb += gridDim.x) {
    const int tok0 = tb * TB;
    if (tb + (int)gridDim.x < ngrp) fin_load(p, nxt, tb + gridDim.x, c, lane, hd);
#pragma unroll
    for (int i = 0; i < TB; ++i) {
      const float mean = wave_sum(cur.y[i]) * (1.f / 64.f);
      const float dlt = cur.y[i] - mean;
      const float var = wave_sum(dlt * dlt) * (1.f / 64.f);
      const float yn = dlt * rsqrtf(var + 64e-5f) * g + bta;
      const float pv1 = bf2f(cur.pv[i + 1]), pv0 = bf2f(cur.pv[i]);
      const float xv = pv1 + (pv0 - pv1) * mu_v;
      const float o = (yn + cur.rkr[i] * xv) * silu(bf2f(cur.z[i]));
      stg[i * 512 + 256 + c] = to_bf16(o);
      stg[i * 512 + c] = cur.cvo[i];
    }
    __syncthreads();
#pragma unroll
    for (int j = 0; j < 2; ++j) {
      const int q = tid + 256 * j, tk = q >> 6, part = q & 63;
      *(u32x4*)(p.mixed + (size_t)(tok0 + tk) * DM + 512 + part * 8) = *(const u32x4*)(stg + tk * 512 + part * 8);
    }
    __syncthreads();
    cur = nxt;
  }
}

template <bool COOP>
__global__ void __launch_bounds__(256, 2) mega(Params p, int ph_begin, int ph_end, int cvar) {
  __shared__ __attribute__((aligned(16))) char smem[SMEM_BYTES];
  XcdBarrier xb;
  if (COOP) {
    volatile unsigned* st = (volatile unsigned*)(smem + 65536 + 16);
    if (threadIdx.x == 0) { st[0] = 0u; st[1] = 0u; }
    __syncthreads();
    xb = xcd_barrier_post(p.bar, st);
  }
#ifdef PROBE_PHASE
  const int n_iter = ph_end + 4;
#else
  const int n_iter = ph_end;
#endif
  for (int itp = ph_begin; itp < n_iter; ++itp) {
    int ph = itp;
#ifdef PROBE_PHASE
    if (itp >= N_PHASES) { ph = 1 + PPL * (itp - N_PHASES) + PROBE_PHASE; cvar = 1; }
#endif
    int tid = threadIdx.x, bid = blockIdx.x;
    asm volatile("" : "+v"(tid));
    asm volatile("" : "+s"(bid));
    if (ph == 0) convert_phase(p, smem, tid, bid);
    else if (ph == N_PHASES - 1) final_norm_phase(p.out, p.final_g, tid, bid);
    else {
      const int l = (ph - 1) / PPL, s = (ph - 1) % PPL;
      switch (s) {
        case 0: norm_phase(l == 0 ? p.x : p.out, p.norm_g + l * DM, p.hbuf, tid, bid); break;
        case 1: gemm_phase<0>(p, l, smem, tid, bid, G1_SPLIT, INC / 128 - 2, 0); break;
        case 2: prep_phase(p, l, smem, tid, bid); break;
        case 3: mix1_phase(p, l, smem, tid, bid); break;
        case 4: mix2_phase(p, l + 4 * cvar, smem, tid, bid); break;
        case 5: rwkv_final_phase(p, l, smem, tid, bid); break;
        default: gemm_phase<1>(p, l, smem, tid, bid, 0, DM / 128, 0); break;
      }
    }
    if (COOP && itp + 1 < n_iter) {
      if (ph_end > 4096) cg::this_grid().sync();
      xcd_barrier(xb);
    }
  }
}

extern "C" void kernel_launch(void* const* d_in, const int* in_sizes, int n_in, void* d_out, int out_size, void* d_ws,
                              size_t ws_size, hipStream_t stream) {
  Params p{};
  const float* const* in = (const float* const*)d_in;
  p.x = in[0]; p.norm_g = in[1]; p.w_in = in[2]; p.w_out = in[3]; p.final_g = in[4]; p.rel_bias = in[5];
  p.lam_qk = in[6]; p.subln_g = in[7]; p.conv_w = in[8]; p.mu = in[9]; p.w0 = in[10]; p.w_up = in[11];
  p.a0 = in[12]; p.a_up = in[13]; p.k_k = in[14]; p.k_a = in[15]; p.r_k = in[16]; p.lnx_g = in[17]; p.lnx_b = in[18];
  p.out = (float*)d_out;
  char* ws = (char*)d_ws;
  size_t off = 0;
  p.bar = (unsigned*)(ws + off); off += 16384;
  p.ctr = (unsigned*)(ws + off); off += 65536 - 16384;
  p.wt_in = (u16*)(ws + off); off += (size_t)DEPTH * INC * DM * 2;
  p.wt_out = (u16*)(ws + off); off += (size_t)DEPTH * DM * DM * 2;
  p.pbuf = (u16*)(ws + off); off += (size_t)NTOK * PS * 2;
  p.vT = (u16*)(ws + off); off += (size_t)NTOK * 512 * 2;
  p.mixed = (u16*)(ws + off); off += (size_t)NTOK * DM * 2;
  p.hbuf = p.mixed;
  p.s_kk = (u16*)(ws + off); off += (size_t)NTOK * 256 * 2;
  p.s_bb = (u16*)(ws + off); off += (size_t)NTOK * 256 * 2;
  p.s_kx = (u16*)(ws + off); off += (size_t)NTOK * 256 * 2;
  p.s_wr = (u16*)(ws + off); off += (size_t)NTOK * 256 * 2;
  p.s_w = (float*)(ws + off); off += (size_t)NTOK * 256 * 4;
  p.s_v = (float*)(ws + off); off += (size_t)NTOK * 256 * 4;
  p.s_sc = (float*)(ws + off); off += (size_t)NTOK * 4 * 4 * 4;
  p.s_state = (float*)(ws + off); off += (size_t)N_SCAN_ITEMS * 256 * 4 * 4;
  if (off > ws_size) { fprintf(stderr, "workspace too small: need %zu have %zu\n", off, ws_size); return; }

  static int grid_blocks = 0;
  if (!grid_blocks) {
    int dev = 0, cus = 0, per_cu = 0;
    hipGetDevice(&dev);
    hipDeviceGetAttribute(&cus, hipDeviceAttributeMultiprocessorCount, dev);
#if ONE_LAUNCH
    hipOccupancyMaxActiveBlocksPerMultiprocessor(&per_cu, mega<true>, 256, 0);
#else
    hipOccupancyMaxActiveBlocksPerMultiprocessor(&per_cu, mega<false>, 256, 0);
#endif
    if (per_cu > 2) per_cu = 2;
    if (per_cu < 1) per_cu = 1;
    grid_blocks = cus * per_cu;
  }
#if ONE_LAUNCH
  hipMemsetAsync(p.bar, 0, 16384, stream);
  int b0 = 0, b1 = N_PHASES, cv = 0;
  void* args[] = {&p, &b0, &b1, &cv};
  hipError_t e = hipLaunchCooperativeKernel((void*)mega<true>, dim3(grid_blocks), dim3(256), args, 0, stream);
  if (e != hipSuccess) fprintf(stderr, "cooperative launch failed: %s (grid %d)\n", hipGetErrorString(e), grid_blocks);
#else
  for (int ph = 0; ph < N_PHASES; ++ph)
    hipLaunchKernelGGL(mega<false>, dim3(grid_blocks), dim3(256), 0, stream, p, ph, ph + 1, 0);
#ifdef PROBE_PHASE
  {
    Params q = p;
    q.out = (float*)p.pbuf; q.x = (const float*)p.pbuf;
    for (int l = 0; l < DEPTH; ++l) {
      const int ph = 1 + PPL * l + PROBE_PHASE;
      hipLaunchKernelGGL(mega<false>, dim3(grid_blocks), dim3(256), 0, stream, (PROBE_PHASE == 5 || PROBE_PHASE == 0) ? q : p, ph, ph + 1, 1);
    }
  }
#endif
#endif
}
```

```cpp
#include <hip/hip_runtime.h>
#include <hip/hip_cooperative_groups.h>
#include <cstdio>
#include <cstdint>
namespace cg = cooperative_groups;

#ifndef ONE_LAUNCH
#define ONE_LAUNCH 1
#endif

typedef unsigned short u16;
typedef __bf16 bf2_t __attribute__((ext_vector_type(2)));
typedef float f2_t __attribute__((ext_vector_type(2)));
using bf16x8 = __attribute__((ext_vector_type(8))) short;
using f32x16 = __attribute__((ext_vector_type(16))) float;
using u32x4 = __attribute__((ext_vector_type(4))) unsigned;
#define DI __device__ __forceinline__
#define MFMA32(a, b, c) __builtin_amdgcn_mfma_f32_32x32x16_bf16((a), (b), (c), 0, 0, 0)

constexpr int NB = 8, SEQ = 4096, DM = 1024, DEPTH = 4, NTOK = NB * SEQ;
constexpr int INC = 4224, PS = 3712;
constexpr int PC_Q = 0, PC_K = 512, PC_ZATT = 1024, PC_CB = 1536, PC_CC = 1792, PC_CH = 2048, PC_ZCONV = 2304,
              PC_RW = 2560, PC_ZRW = 3456;
constexpr int SMEM_BYTES = 65536 + 1024;
constexpr int PPL = 7;
constexpr int N_PHASES = 2 + PPL * DEPTH;
constexpr int SCAN_T1 = 1344;
constexpr int G1_SPLIT = 16;
constexpr int N_SCAN_ITEMS = 128, N_ATT_ITEMS = 1024;

struct Params {
  const float *x, *norm_g, *w_in, *w_out, *final_g, *rel_bias, *lam_qk, *subln_g, *conv_w, *mu, *w0, *w_up, *a0,
      *a_up, *k_k, *k_a, *r_k, *lnx_g, *lnx_b;
  float* out;
  u16 *wt_in, *wt_out, *hbuf, *pbuf, *vT, *mixed;
  u16 *s_kk, *s_bb, *s_kx, *s_wr;
  float *s_w, *s_v, *s_sc, *s_state;
  unsigned *ctr, *bar;
};

DI unsigned pack_bf16(float a, float b) {
  f2_t v = {a, b};
  return __builtin_bit_cast(unsigned, __builtin_convertvector(v, bf2_t));
}
DI u16 to_bf16(float a) { return (u16)(pack_bf16(a, 0.f) & 0xffffu); }
DI float bf_lo(unsigned u) { return __uint_as_float(u << 16); }
DI float bf_hi(unsigned u) { return __uint_as_float(u & 0xffff0000u); }
DI float bf2f(u16 u) { return __uint_as_float(((unsigned)u) << 16); }
template <int CTRL, int RMASK>
DI float dpp_add(float v) {
  const int x = __builtin_amdgcn_update_dpp(0, __builtin_bit_cast(int, v), CTRL, RMASK, 0xF, true);
  return v + __builtin_bit_cast(float, x);
}
DI float wave_sum(float v) {
  v = dpp_add<0xB1, 0xF>(v);
  v = dpp_add<0x4E, 0xF>(v);
  v = dpp_add<0x124, 0xF>(v);
  v = dpp_add<0x128, 0xF>(v);
  v = dpp_add<0x142, 0xA>(v);
  v = dpp_add<0x143, 0xC>(v);
  return __builtin_bit_cast(float, __builtin_amdgcn_readlane(__builtin_bit_cast(int, v), 63));
}
DI int crow(int i, int h) { return (i & 3) + 8 * (i >> 2) + 4 * h; }
DI float silu(float z) { return z / (1.f + __expf(-z)); }

#define XB_TMO 128
#define XB_XCNT(j) (256 + 64 * (j))
#define XB_XSUB(j) (1280 + 64 * (j))
#define XB_XGEN(j) (2304 + 64 * (j))
#define XB_TOP 3328
#define XB_TOPGEN 3392
#define XCD_BAR_WORDS 3456
#define XB_SPIN_CAP (1u << 22)
DI unsigned xb_ld(unsigned* p) { return __hip_atomic_load(p, __ATOMIC_RELAXED, __HIP_MEMORY_SCOPE_AGENT); }
DI unsigned xb_add(unsigned* p, unsigned v) {
  return __hip_atomic_fetch_add(p, v, __ATOMIC_RELAXED, __HIP_MEMORY_SCOPE_AGENT);
}
DI unsigned xb_xcc_id() { return (unsigned)__builtin_amdgcn_s_getreg((3 << 11) | 20) & 0xFu; }
#define XB_SPIN(cond, bar)                                  \
  do {                                                      \
    unsigned _sp = 0;                                       \
    while (cond) {                                          \
      __builtin_amdgcn_s_sleep(1);                          \
      if ((++_sp & 255u) == 0u) {                           \
        if (xb_ld(&(bar)[XB_TMO])) break;                   \
        if (_sp > XB_SPIN_CAP) {                            \
          atomicAdd(&(bar)[XB_TMO], 1u);                    \
          break;                                            \
        }                                                   \
      }                                                     \
    }                                                       \
  } while (0)

struct XcdBarrier {
  unsigned* bar;
  unsigned x;
  volatile unsigned* st;
};
DI XcdBarrier xcd_barrier_post(unsigned* bar, volatile unsigned* st) {
  XcdBarrier b;
  b.bar = bar;
  b.x = xb_xcc_id();
  b.st = st;
  if (threadIdx.x == 0) (void)xb_add(&bar[XB_XCNT(b.x)], 1u);
  return b;
}
DI void xcd_barrier_complete(unsigned* bar, unsigned x, unsigned& nloc, unsigned& nx) {
  const unsigned G = gridDim.x;
  unsigned sum, cnt, mine, sp = 0u;
  for (;;) {
    sum = 0u; cnt = 0u; mine = 0u;
#pragma unroll
    for (unsigned j = 0; j < 16; ++j) {
      const unsigned c = xb_ld(&bar[XB_XCNT(j)]);
      sum += c; cnt += (c > 0u) ? 1u : 0u; mine = (j == x) ? c : mine;
    }
    if (sum == G) break;
    __builtin_amdgcn_s_sleep(1);
    if ((++sp & 255u) == 0u) {
      if (xb_ld(&bar[XB_TMO])) break;
      if (sp > XB_SPIN_CAP) { atomicAdd(&bar[XB_TMO], 1u); break; }
    }
  }
  nloc = mine > 0u ? mine : 1u;
  nx = cnt > 0u ? cnt : 1u;
}
DI void xcd_barrier(const XcdBarrier& b) {
  asm volatile("s_waitcnt vmcnt(0)" ::: "memory");
  __syncthreads();
  if (threadIdx.x == 0) {
    unsigned* bar = b.bar;
    __builtin_amdgcn_s_waitcnt(0);
    unsigned nloc = b.st[0], nx = b.st[1];
    if (nloc == 0u) { xcd_barrier_complete(bar, b.x, nloc, nx); b.st[0] = nloc; b.st[1] = nx; }
    const unsigned old = xb_add(&bar[XB_XSUB(b.x)], 1u);
    const unsigned gen = old / nloc;
    if (old + 1u == (gen + 1u) * nloc) {
      __builtin_amdgcn_fence(__ATOMIC_RELEASE, "agent");
      asm volatile("s_waitcnt vmcnt(0)" ::: "memory");
      const unsigned og = xb_add(&bar[XB_TOP], 1u);
      const unsigned tg = og / nx;
      if (og + 1u == (tg + 1u) * nx) xb_add(&bar[XB_TOPGEN], 1u);
      else XB_SPIN(xb_ld(&bar[XB_TOPGEN]) == tg, bar);
      __builtin_amdgcn_fence(__ATOMIC_ACQUIRE, "agent");
      xb_add(&bar[XB_XGEN(b.x)], 1u);
      asm volatile("s_waitcnt vmcnt(0)" ::: "memory");
    } else {
      XB_SPIN(xb_ld(&bar[XB_XGEN(b.x)]) == gen, bar);
      __builtin_amdgcn_fence(__ATOMIC_ACQUIRE, "agent");
      asm volatile("s_waitcnt vmcnt(0)" ::: "memory");
    }
  }
  __syncthreads();
}

__device__ void convert_phase(const Params& p, char* smem, int tid, int bid) {
  constexpr int T_IN = 16 * 66, T_OUT = 16 * 16, PER_L = T_IN + T_OUT;
  float* tile = (float*)smem;
  const int t = tid;
  if (bid == 0 && t < 128) p.ctr[t] = 0u;
  for (int it = bid; it < DEPTH * PER_L; it += gridDim.x) {
    const int l = it / PER_L;
    int r = it % PER_L;
    const float* src; u16* dst; int N;
    if (r < T_IN) { src = p.w_in + (size_t)l * DM * INC; dst = p.wt_in + (size_t)l * INC * DM; N = INC; }
    else { r -= T_IN; src = p.w_out + (size_t)l * DM * DM; dst = p.wt_out + (size_t)l * DM * DM; N = DM; }
    const int ntn = N / 64, kt = r / ntn, nt = r % ntn;
    {
      const int c4 = (t & 15) * 4, r0 = t >> 4;
      float4 v[4];
#pragma unroll
      for (int i = 0; i < 4; ++i) v[i] = *(const float4*)(src + (size_t)(kt * 64 + r0 + 16 * i) * N + nt * 64 + c4);
#pragma unroll
      for (int i = 0; i < 4; ++i) {
        float* d = tile + (r0 + 16 * i) * 65 + c4;
        d[0] = v[i].x; d[1] = v[i].y; d[2] = v[i].z; d[3] = v[i].w;
      }
    }
    __syncthreads();
    {
      const int n = t >> 2, kc = (t & 3) * 16;
      unsigned w[8];
#pragma unroll
      for (int j = 0; j < 8; ++j) w[j] = pack_bf16(tile[(kc + 2 * j) * 65 + n], tile[(kc + 2 * j + 1) * 65 + n]);
      uint4* d = (uint4*)(dst + (size_t)(nt * 64 + n) * DM + kt * 64 + kc);
      d[0] = make_uint4(w[0], w[1], w[2], w[3]);
      d[1] = make_uint4(w[4], w[5], w[6], w[7]);
    }
    __syncthreads();
  }
}

__device__ void norm_phase(const float* __restrict__ xin, const float* __restrict__ g, u16* __restrict__ h, int tid, int bid) {
  const int lane = tid & 63;
  const int wid = bid * 4 + (tid >> 6), nw = gridDim.x * 4;
  float4 gg[4];
#pragma unroll
  for (int i = 0; i < 4; ++i) gg[i] = ((const float4*)g)[lane + 64 * i];
  float4 v[2][4], nx[2][4];
  if (wid * 2 < NTOK) {
#pragma unroll
    for (int u = 0; u < 2; ++u)
#pragma unroll
      for (int i = 0; i < 4; ++i) v[u][i] = ((const float4*)(xin + (size_t)(wid * 2 + u) * DM))[lane + 64 * i];
  }
  for (int row = wid * 2; row < NTOK; row += nw * 2) {
    if (row + nw * 2 < NTOK) {
#pragma unroll
      for (int u = 0; u < 2; ++u)
#pragma unroll
        for (int i = 0; i < 4; ++i) nx[u][i] = ((const float4*)(xin + (size_t)(row + nw * 2 + u) * DM))[lane + 64 * i];
    }
#pragma unroll
    for (int u = 0; u < 2; ++u) {
      float ss = 0.f;
#pragma unroll
      for (int i = 0; i < 4; ++i) ss += v[u][i].x * v[u][i].x + v[u][i].y * v[u][i].y + v[u][i].z * v[u][i].z + v[u][i].w * v[u][i].w;
      ss = wave_sum(ss);
      const float rs = rsqrtf(ss * (1.f / DM) + 1e-6f);
#pragma unroll
      for (int i = 0; i < 4; ++i) {
        uint2 o;
        o.x = pack_bf16(v[u][i].x * rs * gg[i].x, v[u][i].y * rs * gg[i].y);
        o.y = pack_bf16(v[u][i].z * rs * gg[i].z, v[u][i].w * rs * gg[i].w);
        *(uint2*)(h + (size_t)(row + u) * DM + (lane + 64 * i) * 4) = o;
      }
    }
#pragma unroll
    for (int u = 0; u < 2; ++u)
#pragma unroll
      for (int i = 0; i < 4; ++i) v[u][i] = nx[u][i];
  }
}

__device__ void final_norm_phase(float* __restrict__ x, const float* __restrict__ g, int tid, int bid) {
  const int lane = tid & 63;
  const int wid = bid * 4 + (tid >> 6), nw = gridDim.x * 4;
  float4 gg[4];
#pragma unroll
  for (int i = 0; i < 4; ++i) gg[i] = ((const float4*)g)[lane + 64 * i];
  float4 v[4], nx[4];
  if (wid < NTOK) {
#pragma unroll
    for (int i = 0; i < 4; ++i) v[i] = ((const float4*)(x + (size_t)wid * DM))[lane + 64 * i];
  }
  for (int row = wid; row < NTOK; row += nw) {
    float4* xr = (float4*)(x + (size_t)row * DM);
    if (row + nw < NTOK) {
#pragma unroll
      for (int i = 0; i < 4; ++i) nx[i] = ((const float4*)(x + (size_t)(row + nw) * DM))[lane + 64 * i];
    }
    float ss = 0.f;
#pragma unroll
    for (int i = 0; i < 4; ++i) ss += v[i].x * v[i].x + v[i].y * v[i].y + v[i].z * v[i].z + v[i].w * v[i].w;
    ss = wave_sum(ss);
    const float rs = rsqrtf(ss * (1.f / DM) + 1e-6f);
#pragma unroll
    for (int i = 0; i < 4; ++i) {
      float4 o;
      o.x = v[i].x * rs * gg[i].x; o.y = v[i].y * rs * gg[i].y; o.z = v[i].z * rs * gg[i].z; o.w = v[i].w * rs * gg[i].w;
      xr[lane + 64 * i] = o;
    }
#pragma unroll
    for (int i = 0; i < 4; ++i) v[i] = nx[i];
  }
}

#define LAS __attribute__((address_space(3)))
template <int MODE>
__device__ void gemm_phase(const Params& p, int l, char* smem, int tid, int bid, int nt_lo, int nt_hi, int local_skip) {
  constexpr int K = DM, BK = 32, NKT = K / BK;
  constexpr int N = MODE == 0 ? INC : DM;
  constexpr int NT = N / 128;
  constexpr int STAGE = 24576;
  const u16* __restrict__ A = MODE == 0 ? p.hbuf : p.mixed;
  const u16* __restrict__ Wt = MODE == 0 ? p.wt_in + (size_t)l * INC * DM : p.wt_out + (size_t)l * DM * DM;
  LAS char* lds = (LAS char*)smem;
  const int lane = tid & 63, w = tid >> 6, r = lane & 31, hh = lane >> 5;
  const int wm = w >> 1, wn = w & 1;
  const int sw = (r >> 2) & 3;
  const int drow = lane >> 2;
  const int dcol = ((lane & 3) ^ ((drow >> 2) & 3)) * 8;
  const int xcd = bid & 7, local = (bid >> 3) - local_skip;
  const int nlocal = ((gridDim.x - xcd + 7) >> 3) - local_skip;
  const int NTR = nt_hi - nt_lo;
  (void)NT;
  for (int j = local; j < 16 * NTR; j += nlocal) {
    const int pnl = j / (8 * NTR), rr = j % (8 * NTR);
    int nt = nt_lo + (rr >> 3);
    if (MODE == 0 && nt_lo == 0 && nt >= G1_SPLIT) nt += INC / 128 - 2 - G1_SPLIT;
    const int mt = 16 * xcd + 8 * pnl + (rr & 7);
    const int m0 = mt * 256, n0 = nt * 128;
    const int wu = __builtin_amdgcn_readfirstlane(w);
    const unsigned loff = (unsigned)(drow * K + dcol);
    const u16* gbase[6];
#pragma unroll
    for (int q = 0; q < 6; ++q) {
      const int G = wu * 6 + q;
      gbase[q] = (G < 16) ? A + (size_t)(m0 + G * 16) * K : Wt + (size_t)(n0 + (G - 16) * 16) * K;
    }
#define gsrc_(q) (gbase[q] + loff)
    f32x16 acc[4][2];
#pragma unroll
    for (int a = 0; a < 4; ++a)
#pragma unroll
      for (int b = 0; b < 2; ++b)
#pragma unroll
        for (int i = 0; i < 16; ++i) acc[a][b][i] = 0.f;
#define GEMM_DMA(stg, kt_)                                                                                   \
  do {                                                                                                       \
    _Pragma("unroll") for (int q = 0; q < 6; ++q)                                                            \
        __builtin_amdgcn_global_load_lds((const unsigned*)(gsrc_(q) + (kt_) * BK),                            \
                                         (LAS unsigned*)(lds + (stg) * STAGE + (w * 6 + q) * 1024), 16, 0, 0); \
  } while (0)
#define GEMM_FRAGS(fa_, fb_, stg, ks)                                                                        \
  do {                                                                                                       \
    const LAS char* a_s_ = lds + (stg) * STAGE;                                                              \
    const int ch_ = ((2 * (ks) + hh) ^ sw) << 4;                                                             \
    _Pragma("unroll") for (int ms = 0; ms < 4; ++ms)                                                         \
        fa_[ms] = *(const LAS bf16x8*)(a_s_ + (wm * 128 + ms * 32 + r) * 64 + ch_);                         \
    _Pragma("unroll") for (int ns = 0; ns < 2; ++ns)                                                         \
        fb_[ns] = *(const LAS bf16x8*)(a_s_ + 16384 + (wn * 64 + ns * 32 + r) * 64 + ch_);                   \
  } while (0)
#define GEMM_MMA(fa_, fb_)                                                                                   \
  do {                                                                                                       \
    __builtin_amdgcn_s_setprio(1);                                                                           \
    _Pragma("unroll") for (int ms = 0; ms < 4; ++ms)                                                         \
        _Pragma("unroll") for (int ns = 0; ns < 2; ++ns) acc[ms][ns] = MFMA32(fb_[ns], fa_[ms], acc[ms][ns]); \
    __builtin_amdgcn_s_setprio(0);                                                                           \
  } while (0)
    bf16x8 a0[4], b0[2], a1[4], b1[2];
    GEMM_DMA(0, 0);
    asm volatile("s_waitcnt vmcnt(0)" ::: "memory");
    __syncthreads();
    GEMM_DMA(1, 1);
    GEMM_FRAGS(a0, b0, 0, 0);
    for (int kt = 0; kt < NKT; ++kt) {
      const int stg = kt & 1;
      GEMM_FRAGS(a1, b1, stg, 1);
      __builtin_amdgcn_sched_barrier(0);
      GEMM_MMA(a0, b0);
      __builtin_amdgcn_sched_barrier(0);
      asm volatile("s_waitcnt vmcnt(0)" ::: "memory");
      __syncthreads();
      if (kt + 2 < NKT) GEMM_DMA(stg, kt + 2);
      if (kt + 1 < NKT) GEMM_FRAGS(a0, b0, stg ^ 1, 0);
      __builtin_amdgcn_sched_barrier(0);
      GEMM_MMA(a1, b1);
      __builtin_amdgcn_sched_barrier(0);
    }
    __syncthreads();
    if (MODE == 0) {
      char* img = smem + w * 9216;
#pragma unroll
      for (int half = 0; half < 2; ++half) {
#pragma unroll
        for (int m2 = 0; m2 < 2; ++m2)
#pragma unroll
          for (int ns = 0; ns < 2; ++ns)
#pragma unroll
            for (int g = 0; g < 4; ++g) {
              uint2 v;
              v.x = pack_bf16(acc[2 * half + m2][ns][4 * g + 0], acc[2 * half + m2][ns][4 * g + 1]);
              v.y = pack_bf16(acc[2 * half + m2][ns][4 * g + 2], acc[2 * half + m2][ns][4 * g + 3]);
              *(uint2*)(img + (m2 * 32 + r) * 144 + (ns * 32 + 8 * g + 4 * hh) * 2) = v;
            }
        asm volatile("s_waitcnt lgkmcnt(0)" ::: "memory");
        const int tb = m0 + wm * 128 + half * 64;
        if (n0 >= 1024 && n0 < 1536) {
          const u16* im = (const u16*)img;
          const int bb = tb >> 12, sq = tb & 4095;
          const int c = lane & 7;
#pragma unroll
          for (int jj = 0; jj < 8; ++jj) {
            const int n = (lane >> 3) + 8 * jj;
            const int dv = n0 - 1024 + wn * 64 + n;
            unsigned e[8];
#pragma unroll
            for (int q = 0; q < 8; ++q)
              e[q] = im[(16 * (c >> 1) + 4 * (c & 1) + (q & 3) + 8 * (q >> 2)) * 72 + n];
            u32x4 v;
            v.x = e[0] | (e[1] << 16); v.y = e[2] | (e[3] << 16); v.z = e[4] | (e[5] << 16); v.w = e[6] | (e[7] << 16);
            *(u32x4*)(p.vT + ((size_t)((bb * 4 + (dv >> 7)) * 128 + (dv & 127))) * SEQ + sq + 8 * c) = v;
          }
        } else {
          const int colb = (n0 < 1024 ? n0 : n0 - 512) + wn * 64 + (lane & 7) * 8;
#pragma unroll
          for (int jj = 0; jj < 8; ++jj) {
            const int row = (lane >> 3) + 8 * jj;
            const u32x4 v = *(const u32x4*)(img + row * 144 + (lane & 7) * 16);
            *(u32x4*)(p.pbuf + (size_t)(tb + row) * PS + colb) = v;
          }
        }
        if (half == 1) __syncthreads(); else asm volatile("s_waitcnt lgkmcnt(0)" ::: "memory");
      }
    } else {
      const float* xold = (l == 0) ? p.x : p.out;
      float* img = (float*)(smem + w * 8704);
      const size_t idx0 = (size_t)(m0 + wm * 128 + (lane >> 4)) * DM + n0 + wn * 64 + (lane & 15) * 4;
      float4 xc[8], xn[8];
#pragma unroll
      for (int jj = 0; jj < 8; ++jj) xc[jj] = *(const float4*)(xold + idx0 + (size_t)(4 * jj) * DM);
#pragma unroll
      for (int ms = 0; ms < 4; ++ms) {
        if (ms < 3) {
#pragma unroll
          for (int jj = 0; jj < 8; ++jj) xn[jj] = *(const float4*)(xold + idx0 + (size_t)((ms + 1) * 32 + 4 * jj) * DM);
        }
#pragma unroll
        for (int ns = 0; ns < 2; ++ns)
#pragma unroll
          for (int g = 0; g < 4; ++g)
            *(float4*)(img + r * 68 + ns * 32 + 8 * g + 4 * hh) =
                make_float4(acc[ms][ns][4 * g + 0], acc[ms][ns][4 * g + 1], acc[ms][ns][4 * g + 2], acc[ms][ns][4 * g + 3]);
        asm volatile("s_waitcnt lgkmcnt(0)" ::: "memory");
#pragma unroll
        for (int jj = 0; jj < 8; ++jj) {
          const int row = (lane >> 4) + 4 * jj, chunk = lane & 15;
          const float4 a4 = *(const float4*)(img + row * 68 + chunk * 4);
          float4 x = xc[jj];
          x.x += a4.x; x.y += a4.y; x.z += a4.z; x.w += a4.w;
          *(float4*)(p.out + idx0 + (size_t)(ms * 32 + 4 * jj) * DM) = x;
        }
        if (ms == 3) __syncthreads(); else asm volatile("s_waitcnt lgkmcnt(0)" ::: "memory");
#pragma unroll
        for (int jj = 0; jj < 8; ++jj) xc[jj] = xn[jj];
      }
    }
  }
}

struct PrepRaw { u16 r, k, v, l, cb, cc, ch, z; };
DI void prep_load(PrepRaw& n, const u16* q, int c, int lcol) {
  n.r = q[PC_RW + c]; n.k = q[PC_RW + 256 + c]; n.v = q[PC_RW + 512 + c]; n.l = q[lcol];
  n.cb = q[PC_CB + c]; n.cc = q[PC_CC + c]; n.ch = q[PC_CH + c]; n.z = q[PC_ZCONV + c];
}
using f32x4v = __attribute__((ext_vector_type(4))) float;
#define MFMA16(a, b, c) __builtin_amdgcn_mfma_f32_16x16x32_bf16((a), (b), (c), 0, 0, 0)
__device__ void prep_phase(const Params& p, int l, char* smem, int tid, int bid) {
  u16* Xs = (u16*)smem;
  float* DWs = (float*)(smem + 8192);
  float* DAs = (float*)(smem + 24832);
  const int c = tid, lane = c & 63, hd = c >> 6;
  const int quad = lane >> 4, l15 = lane & 15;
  bf16x8 wf[4][2], af[4][2];
  {
    const float* wu = p.w_up + (size_t)l * 64 * 256;
    const float* au = p.a_up + (size_t)l * 64 * 256;
#pragma unroll
    for (int nt = 0; nt < 4; ++nt)
#pragma unroll
      for (int ks = 0; ks < 2; ++ks) {
        const int ch = 64 * hd + 16 * nt + l15, k0 = ks * 32 + quad * 8;
        u32x4 tw, ta;
        tw.x = pack_bf16(wu[(k0 + 0) * 256 + ch], wu[(k0 + 1) * 256 + ch]);
        tw.y = pack_bf16(wu[(k0 + 2) * 256 + ch], wu[(k0 + 3) * 256 + ch]);
        tw.z = pack_bf16(wu[(k0 + 4) * 256 + ch], wu[(k0 + 5) * 256 + ch]);
        tw.w = pack_bf16(wu[(k0 + 6) * 256 + ch], wu[(k0 + 7) * 256 + ch]);
        ta.x = pack_bf16(au[(k0 + 0) * 256 + ch], au[(k0 + 1) * 256 + ch]);
        ta.y = pack_bf16(au[(k0 + 2) * 256 + ch], au[(k0 + 3) * 256 + ch]);
        ta.z = pack_bf16(au[(k0 + 4) * 256 + ch], au[(k0 + 5) * 256 + ch]);
        ta.w = pack_bf16(au[(k0 + 6) * 256 + ch], au[(k0 + 7) * 256 + ch]);
        wf[nt][ks] = __builtin_bit_cast(bf16x8, tw);
        af[nt][ks] = __builtin_bit_cast(bf16x8, ta);
      }
  }
  const float* mu = p.mu + l * 896;
  const float mu_r = mu[c], mu_k = mu[256 + c], mu_v = mu[512 + c];
  const int xcol = c & 127, xhalf = c >> 7;
  const float mu_l = mu[768 + xcol];
  const float w0c = p.w0[l * 256 + c], a0c = p.a0[l * 256 + c], kkc = p.k_k[l * 256 + c], kac = p.k_a[l * 256 + c],
              rkc = p.r_k[l * 256 + c];
  const float cw0 = p.conv_w[l * 768 + c], cw1 = p.conv_w[l * 768 + 256 + c], cw2 = p.conv_w[l * 768 + 512 + c];
  for (int tile = bid; tile < NTOK / 64; tile += gridDim.x) {
    const int tok0 = tile * 64;
    const int b = tok0 >> 12, s0 = tok0 & 4095;
    float pr = 0.f, pk = 0.f, pv = 0.f, u1 = 0.f, u2 = 0.f;
    if (s0 > 0) {
      const u16* q = p.pbuf + (size_t)(tok0 - 1) * PS;
      pr = bf2f(q[PC_RW + c]); pk = bf2f(q[PC_RW + 256 + c]); pv = bf2f(q[PC_RW + 512 + c]);
      u1 = bf2f(q[PC_CC + c]) * bf2f(q[PC_CH + c]);
      const u16* q2 = q - PS;
      u2 = bf2f(q2[PC_CC + c]) * bf2f(q2[PC_CH + c]);
    }
    u16 raw[9], rawn[9];
    {
      const int tb = tok0 + 8 * xhalf;
      const u16* q = p.pbuf + (size_t)tb * PS + PC_RW + 768 + xcol;
      raw[0] = ((tb & 4095) > 0) ? *(q - PS) : (u16)0;
#pragma unroll
      for (int e = 0; e < 8; ++e) raw[e + 1] = q[(size_t)e * PS];
    }
    PrepRaw cur4[4], nxt4[4];
#pragma unroll
    for (int i4 = 0; i4 < 4; ++i4) prep_load(cur4[i4], p.pbuf + (size_t)(tok0 + i4) * PS, c, PC_RW + c);
    for (int st = 0; st < 4; ++st) {
      const int T0 = tok0 + 16 * st;
      {
        if (st < 3) {
          const int tb = T0 + 16 + 8 * xhalf;
          const u16* q = p.pbuf + (size_t)tb * PS + PC_RW + 768 + xcol;
          rawn[0] = *(q - PS);
#pragma unroll
          for (int e = 0; e < 8; ++e) rawn[e + 1] = q[(size_t)e * PS];
        }
#pragma unroll
        for (int e = 0; e < 8; ++e) {
          const float cur = bf2f(raw[e + 1]), prv = bf2f(raw[e]);
          const float xl = cur + (prv - cur) * mu_l;
          const float val = (xcol < 64) ? (1.f - 2.f / (1.f + __expf(2.f * xl))) : xl;
          Xs[(8 * xhalf + e) * 136 + xcol] = to_bf16(val);
        }
#pragma unroll
        for (int e = 0; e < 9; ++e) raw[e] = rawn[e];
      }
      __syncthreads();
      {
        bf16x8 xa[4];
#pragma unroll
        for (int k4 = 0; k4 < 4; ++k4) xa[k4] = *(const bf16x8*)(Xs + l15 * 136 + k4 * 32 + quad * 8);
#pragma unroll
        for (int nt = 0; nt < 4; ++nt) {
          f32x4v dw = {0.f, 0.f, 0.f, 0.f}, da = {0.f, 0.f, 0.f, 0.f};
          dw = MFMA16(xa[0], wf[nt][0], dw);
          dw = MFMA16(xa[1], wf[nt][1], dw);
          da = MFMA16(xa[2], af[nt][0], da);
          da = MFMA16(xa[3], af[nt][1], da);
          const int ch = 64 * hd + 16 * nt + l15;
#pragma unroll
          for (int j = 0; j < 4; ++j) {
            DWs[(quad * 4 + j) * 260 + ch] = dw[j];
            DAs[(quad * 4 + j) * 260 + ch] = da[j];
          }
        }
      }
      __syncthreads();
      u16* SB = (u16*)(smem + 41472);
      float* SF = (float*)(smem + 41472 + 8192);
      u16* SCV = (u16*)(smem + 41472 + 16384);
      float* SSC = (float*)(smem + 41472 + 18432);
      for (int g = 0; g < 4; ++g) {
        if (g < 3 || st < 3) {
#pragma unroll
          for (int i4 = 0; i4 < 4; ++i4) prep_load(nxt4[i4], p.pbuf + (size_t)(T0 + 4 * g + 4 + i4) * PS, c, PC_RW + c);
        }
#pragma unroll
        for (int i4 = 0; i4 < 4; ++i4) {
          const int i = g * 4 + i4;
          const int tok = T0 + i;
          const PrepRaw nx = cur4[i4];
          const float cr = bf2f(nx.r), ck = bf2f(nx.k), cv = bf2f(nx.v);
          const float ccb = bf2f(nx.cb), ccc = bf2f(nx.cc), cch = bf2f(nx.ch), cz = bf2f(nx.z);
          {
            const float uu = ccc * cch;
            const float y = cw0 * u2 + cw1 * u1 + cw2 * uu;
            u2 = u1; u1 = uu;
            SCV[i4 * 256 + c] = to_bf16(ccb * y * silu(cz));
          }
          const float xr = cr + (pr - cr) * mu_r, xk = ck + (pk - ck) * mu_k, xv = cv + (pv - cv) * mu_v;
          pr = cr; pk = ck; pv = cv;
          const float dws = DWs[i * 260 + c], das = DAs[i * 260 + c];
          const float wz = -(w0c + dws);
          const float sp = (wz > 20.f) ? wz : __logf(1.f + __expf(wz));
          const float decay = __expf(-__expf(-sp - 0.5f));
          const float a = 1.f / (1.f + __expf(-(a0c + das)));
          const float kkv = xk * kkc;
          const float ssq = wave_sum(kkv * kkv);
          const float kk = kkv / fmaxf(sqrtf(ssq), 1e-12f);
          const float kmod = xk * (1.f + (a - 1.f) * kac);
          const float bb = kk * a;
          const float wr = decay * xr;
          const float br = wave_sum(bb * xr);
          const float kr = wave_sum(kmod * xr);
          const float rkr = wave_sum(xr * kmod * rkc);
          SB[(0 * 4 + i4) * 256 + c] = to_bf16(kk);
          SB[(1 * 4 + i4) * 256 + c] = to_bf16(bb);
          SB[(2 * 4 + i4) * 256 + c] = to_bf16(kmod);
          SB[(3 * 4 + i4) * 256 + c] = to_bf16(wr);
          SF[(0 * 4 + i4) * 256 + c] = decay;
          SF[(1 * 4 + i4) * 256 + c] = xv;
          if (lane == 0) {
            *(float4*)(SSC + (i4 * 4 + hd) * 8) = make_float4(br, kr, rkr, 0.f);
          }
        }
        __syncthreads();
        {
          const int tg = s0 + 16 * st + 4 * g;
          {
            const int sel = tid >> 7, q = tid & 127, pr_ = q >> 3, part = q & 7;
            const int tk = pr_ >> 2, hq = pr_ & 3;
            const size_t rec = (size_t)(b * 4 + hq) * SEQ + tg + tk;
            const u32x4 v0 = *(const u32x4*)(SB + ((2 * sel) * 4 + tk) * 256 + hq * 64 + part * 8);
            const u32x4 v1 = *(const u32x4*)(SB + ((2 * sel + 1) * 4 + tk) * 256 + hq * 64 + part * 8);
            u16* d0 = sel ? p.s_kx : p.s_kk;
            u16* d1 = sel ? p.s_wr : p.s_bb;
            *(u32x4*)(d0 + rec * 64 + part * 8) = v0;
            *(u32x4*)(d1 + rec * 64 + part * 8) = v1;
          }
          {
            const int pr_ = tid >> 4, part = tid & 15;
            const int tk = pr_ >> 2, hq = pr_ & 3;
            const size_t rec = (size_t)(b * 4 + hq) * SEQ + tg + tk;
            *(u32x4*)(p.s_w + rec * 64 + part * 4) = *(const u32x4*)(SF + (0 * 4 + tk) * 256 + hq * 64 + part * 4);
            *(u32x4*)(p.s_v + rec * 64 + part * 4) = *(const u32x4*)(SF + (1 * 4 + tk) * 256 + hq * 64 + part * 4);
          }
          if (tid < 128) {
            const int tk = tid >> 5, part = tid & 31;
            *(u32x4*)(p.pbuf + (size_t)(T0 + 4 * g + tk) * PS + PC_CB + part * 8) = *(const u32x4*)(SCV + tk * 256 + part * 8);
          } else if (tid < 144) {
            const int pr_ = tid - 128;
            const int tk = pr_ >> 2, hq = pr_ & 3;
            const size_t rec = (size_t)(b * 4 + hq) * SEQ + tg + tk;
            *(float4*)(p.s_sc + rec * 4) = *(const float4*)(SSC + pr_ * 8);
          }
        }
        __syncthreads();
#pragma unroll
        for (int i4 = 0; i4 < 4; ++i4) cur4[i4] = nxt4[i4];
      }
    }
    __syncthreads();
  }
}

DI float dpp_xor1(float v) {
  return __builtin_bit_cast(float, __builtin_amdgcn_update_dpp(0, __builtin_bit_cast(int, v), 0xB1, 0xF, 0xF, true));
}
DI float dpp_xor2(float v) {
  return __builtin_bit_cast(float, __builtin_amdgcn_update_dpp(0, __builtin_bit_cast(int, v), 0x4E, 0xF, 0xF, true));
}
constexpr int SC_STEP = 340, SC_TC = 16, SC_BUF = SC_STEP * SC_TC;
struct ScanRegs { u32x4 a, b, w, v; float4 sc; };

DI void scan_load(const Params& p, int bh, int quarter, int chunk, int tid, ScanRegs& R) {
  const size_t base = ((size_t)bh * SEQ + chunk * SC_TC) * 64;
  const int c = tid & 127;
  const u16* pa = (tid < 128) ? p.s_kk : p.s_bb;
  const u16* pb = (tid < 128) ? p.s_kx : p.s_wr;
  R.a = *(const u32x4*)(pa + base + c * 8);
  R.b = *(const u32x4*)(pb + base + c * 8);
  R.w = *(const u32x4*)(p.s_w + base + tid * 4);
  if (tid < 64) {
    const int st = tid >> 2, q = tid & 3;
    R.v = *(const u32x4*)(p.s_v + base + st * 64 + quarter * 16 + q * 4);
  } else if (tid >= 128 && tid < 144) {
    R.sc = *(const float4*)(p.s_sc + ((size_t)bh * SEQ + chunk * SC_TC + (tid - 128)) * 4);
  }
}
DI void scan_cvt_store(float* d, u32x4 u) {
  *(float4*)(d) = make_float4(bf_lo(u.x), bf_hi(u.x), bf_lo(u.y), bf_hi(u.y));
  *(float4*)(d + 4) = make_float4(bf_lo(u.z), bf_hi(u.z), bf_lo(u.w), bf_hi(u.w));
}
DI void scan_store(float* buf, int tid, const ScanRegs& R) {
  {
    const int c = tid & 127, st = c >> 3, q = c & 7;
    float* d = buf + st * SC_STEP + q * 8;
    scan_cvt_store(d + (tid < 128 ? 0 : 64), R.a);
    scan_cvt_store(d + (tid < 128 ? 192 : 256), R.b);
  }
  {
    const int e = tid * 4;
    *(u32x4*)(buf + (e >> 6) * SC_STEP + 128 + (e & 63)) = R.w;
  }
  if (tid < 64) {
    const int st = tid >> 2, q = tid & 3;
    *(u32x4*)(buf + st * SC_STEP + 320 + q * 4) = R.v;
  } else if (tid >= 128 && tid < 144) {
    *(float4*)(buf + (tid - 128) * SC_STEP + 336) = R.sc;
  }
}

struct StepOps { f2_t kk[2], bb[2], ww[2], kx[2], wr[2]; float vv; f2_t bk; };
DI void step_load(StepOps& o, const float* sb, int kq, int row) {
  const f2_t* q = (const f2_t*)(sb + kq * 4);
#pragma unroll
  for (int j = 0; j < 2; ++j) {
    o.kk[j] = q[j];
    o.bb[j] = q[32 + j];
    o.ww[j] = q[64 + j];
    o.kx[j] = q[96 + j];
    o.wr[j] = q[128 + j];
  }
  o.vv = sb[320 + row];
  o.bk = *(const f2_t*)(sb + 336);
}
template <int CTRL>
DI float dpp_mov(float v) {
  return __builtin_bit_cast(float, __builtin_amdgcn_update_dpp(0, __builtin_bit_cast(int, v), CTRL, 0xF, 0xF, true));
}
DI void step_compute(f2_t (&S)[2], const StepOps& o, float& ykeep, bool keep) {
  f2_t sa2 = S[0] * o.kk[0], yd2 = S[0] * o.wr[0];
  sa2 += S[1] * o.kk[1];
  yd2 += S[1] * o.wr[1];
  float sa = sa2.x + sa2.y, yd = yd2.x + yd2.y;
  sa += dpp_mov<0xB1>(sa); yd += dpp_mov<0xB1>(yd);
  sa += dpp_mov<0x4E>(sa); yd += dpp_mov<0x4E>(yd);
  sa += dpp_mov<0x124>(sa); yd += dpp_mov<0x124>(yd);
  sa += dpp_mov<0x128>(sa); yd += dpp_mov<0x128>(yd);
  const f2_t vv2 = {o.vv, o.vv}, sa2b = {sa, sa};
#pragma unroll
  for (int j = 0; j < 2; ++j) {
    f2_t t = vv2 * o.kx[j];
    t = t - sa2b * o.bb[j];
    S[j] = S[j] * o.ww[j] + t;
  }
  const float y = yd - sa * o.bk.x + o.vv * o.bk.y;
  ykeep = keep ? y : ykeep;
}

__device__ void scan_item(const Params& p, int item, char* smem, int tid, int ch0, int ch1) {
  float* lds = (float*)smem;
  const int bh = item >> 2, quarter = item & 3;
  const int w = tid >> 6, lane = tid & 63;
  const int NCH = SEQ / SC_TC;
  ScanRegs R;
  f2_t S[2];
  float4* const stp = (float4*)(p.s_state) + (size_t)item * 256 + tid;
  if (ch0 == 0) {
    S[0] = f2_t{0.f, 0.f};
    S[1] = f2_t{0.f, 0.f};
  } else {
    const float4 sv = *stp;
    S[0] = f2_t{sv.x, sv.y};
    S[1] = f2_t{sv.z, sv.w};
  }
  const int row = (lane >> 4) + 4 * w;
  const int kq = lane & 15;
  __syncthreads();
  (void)NCH;
  scan_load(p, bh, quarter, ch0, tid, R);
  scan_store(lds + (ch0 & 1) * SC_BUF, tid, R);
  scan_load(p, bh, quarter, ch0 + 1, tid, R);
  __syncthreads();
  for (int ch = ch0; ch < ch1; ++ch) {
    const float* buf = lds + (ch & 1) * SC_BUF;
    if (ch + 1 < ch1) scan_store(lds + ((ch + 1) & 1) * SC_BUF, tid, R);
    if (ch + 2 < ch1) scan_load(p, bh, quarter, ch + 2, tid, R);
    float ykeep = 0.f;
    StepOps o0, o1;
    step_load(o0, buf, kq, row);
#pragma unroll
    for (int st = 0; st < SC_TC; st += 2) {
      step_load(o1, buf + (st + 1) * SC_STEP, kq, row);
      step_compute(S, o0, ykeep, kq == st);
      if (st + 2 < SC_TC) step_load(o0, buf + (st + 2) * SC_STEP, kq, row);
      step_compute(S, o1, ykeep, kq == st + 1);
    }
    p.s_v[((size_t)bh * SEQ + ch * SC_TC + kq) * 64 + quarter * 16 + row] = ykeep;
    __syncthreads();
  }
  if (ch1 < SEQ / SC_TC) *stp = make_float4(S[0].x, S[0].y, S[1].x, S[1].y);
}

DI void vstore(char* lo, char* hi, u32x4 a, u32x4 b, u32x4 c, u32x4 d) {
  *(uint2*)(lo) = make_uint2(a.x, a.y); *(uint2*)(hi) = make_uint2(a.z, a.w);
  *(uint2*)(lo + 4096) = make_uint2(b.x, b.y); *(uint2*)(hi + 4096) = make_uint2(b.z, b.w);
  *(uint2*)(lo + 8192) = make_uint2(c.x, c.y); *(uint2*)(hi + 8192) = make_uint2(c.z, c.w);
  *(uint2*)(lo + 12288) = make_uint2(d.x, d.y); *(uint2*)(hi + 12288) = make_uint2(d.z, d.w);
}
__device__ void attn_item(const Params& p, int l, int a, float lam, float one_minus_li, char* smem, int tid) {
  const int qb = 31 - (a >> 5), bhx = a & 31, b = bhx >> 2, h = bhx & 3;
  const int t = tid, lane = t & 63, w = t >> 6, r = lane & 31, hh = lane >> 5;
  const int sw = (r >> 1) & 7;
  const int q0 = qb * 128;
  const int qpos = q0 + w * 32 + r;
  const size_t tokq = (size_t)b * SEQ + qpos;
  float* lut = (float*)(smem + 49152);
  const float LOG2E = 1.4426950408889634f;
  __syncthreads();
  {
    const int d = t - 128;
    float v = -1e30f;
    if (d >= 0) {
      int bk;
      if (d < 16) bk = d;
      else {
        bk = 16 + (int)(logf((float)d / 16.f) / logf(8.f) * 16.f);
        bk = bk > 31 ? 31 : bk;
      }
      v = p.rel_bias[bk * 4 + h] * LOG2E;
    }
    lut[t] = v;
  }
  const float cbias = p.rel_bias[31 * 4 + h] * LOG2E;
  const int dq = qpos - 4 * hh;
  const float sc = 0.125f * LOG2E;
  const int ntiles = 2 * (qb + 1);
  const int lc = t & 7, lr = t >> 3;
  const unsigned ldsw = lr * 128 + ((lc ^ ((lr >> 1) & 7)) << 4);
  const int drl = lane >> 3, dpc = lane & 7;
  const int dc0 = (dpc ^ (drl >> 1)) * 8;
  const int dc1 = (dpc ^ (4 + (drl >> 1))) * 8;
  const u16* vsrc0 = p.vT + ((size_t)((b * 4 + h) * 128 + w * 32 + drl)) * SEQ;
  LAS char* ldsl = (LAS char*)smem;
  (void)lc; (void)lr; (void)ldsw;
#pragma unroll
  for (int m = 0; m < 2; ++m) {
    const u16* ksrc0 = p.pbuf + ((size_t)b * SEQ + w * 16 + drl) * PS + PC_K + h * 128 + m * 64;
    bf16x8 qf[4];
    {
      const u16* qp = p.pbuf + tokq * PS + PC_Q + h * 128 + m * 64 + hh * 8;
#pragma unroll
      for (int ks = 0; ks < 4; ++ks) qf[ks] = *(const bf16x8*)(qp + ks * 16);
    }
    f32x16 O[4];
#pragma unroll
    for (int d = 0; d < 4; ++d)
#pragma unroll
      for (int i = 0; i < 16; ++i) O[d][i] = 0.f;
    float m_i = -1e30f, l_i = 0.f;
    __syncthreads();
#define ATT_STAGE(buf, kk0)                                                                                             \
  do {                                                                                                                  \
    __builtin_amdgcn_global_load_lds((const unsigned*)(ksrc0 + (size_t)(kk0) * PS + dc0),                               \
                                     (LAS unsigned*)(ldsl + (buf) * 8192 + (w * 2) * 1024), 16, 0, 0);                  \
    __builtin_amdgcn_global_load_lds((const unsigned*)(ksrc0 + (size_t)((kk0) + 8) * PS + dc1),                         \
                                     (LAS unsigned*)(ldsl + (buf) * 8192 + (w * 2 + 1) * 1024), 16, 0, 0);              \
    _Pragma("unroll") for (int q_ = 0; q_ < 4; ++q_)                                                                   \
        __builtin_amdgcn_global_load_lds((const unsigned*)(vsrc0 + (size_t)(q_ * 8) * SEQ + (kk0) + ((q_ & 1) ? dc1 : dc0)), \
                                         (LAS unsigned*)(ldsl + 16384 + (buf) * 16384 + (w * 4 + q_) * 1024), 16, 0, 0); \
  } while (0)
    ATT_STAGE(0, 0);
    asm volatile("s_waitcnt vmcnt(0)" ::: "memory");
    __syncthreads();
    for (int kt = 0; kt < ntiles; ++kt) {
      const int k0 = kt * 64;
      if (kt + 1 < ntiles) ATT_STAGE((kt + 1) & 1, k0 + 64);
      const char* k_s = smem + (kt & 1) * 8192;
      const char* v_s = smem + 16384 + (kt & 1) * 16384;
      f32x16 sacc[2];
#pragma unroll
      for (int sub = 0; sub < 2; ++sub) {
#pragma unroll
        for (int i = 0; i < 16; ++i) sacc[sub][i] = 0.f;
#pragma unroll
        for (int ks = 0; ks < 4; ++ks) {
          const bf16x8 kf = *(const bf16x8*)(k_s + (sub * 32 + r) * 128 + (((2 * ks + hh) ^ sw) << 4));
          sacc[sub] = MFMA32(kf, qf[ks], sacc[sub]);
        }
      }
      float rs = 0.f, alpha;
      if (kt + 4 >= ntiles) {
        float mx = -1e30f;
#pragma unroll
        for (int sub = 0; sub < 2; ++sub)
#pragma unroll
          for (int i = 0; i < 16; ++i) {
            const int d = dq - k0 - (sub * 32 + (i & 3) + 8 * (i >> 2));
            const int di = d < -128 ? -128 : (d > 127 ? 127 : d);
            const float sv = sacc[sub][i] * sc + lut[di + 128];
            sacc[sub][i] = sv;
            mx = fmaxf(mx, sv);
          }
        mx = fmaxf(mx, __shfl_xor(mx, 32, 64));
        const float m_new = fmaxf(m_i, mx);
        alpha = __builtin_amdgcn_exp2f(m_i - m_new);
        m_i = m_new;
#pragma unroll
        for (int sub = 0; sub < 2; ++sub)
#pragma unroll
          for (int i = 0; i < 16; ++i) {
            const float pe = __builtin_amdgcn_exp2f(sacc[sub][i] - m_new);
            sacc[sub][i] = pe;
            rs += pe;
          }
      } else {
        float mx = -1e30f;
#pragma unroll
        for (int sub = 0; sub < 2; ++sub)
#pragma unroll
          for (int i = 0; i < 16; ++i) mx = fmaxf(mx, sacc[sub][i]);
        mx = fmaxf(mx, __shfl_xor(mx, 32, 64));
        const float m_new = fmaxf(m_i, mx * sc + cbias);
        alpha = __builtin_amdgcn_exp2f(m_i - m_new);
        m_i = m_new;
        const float off = cbias - m_new;
#pragma unroll
        for (int sub = 0; sub < 2; ++sub)
#pragma unroll
          for (int i = 0; i < 16; ++i) {
            const float pe = __builtin_amdgcn_exp2f(sacc[sub][i] * sc + off);
            sacc[sub][i] = pe;
            rs += pe;
          }
      }
      l_i = l_i * alpha + rs;
      if (__any(alpha != 1.f)) {
#pragma unroll
        for (int d = 0; d < 4; ++d)
#pragma unroll
          for (int i = 0; i < 16; ++i) O[d][i] *= alpha;
      }
#pragma unroll
      for (int kst = 0; kst < 4; ++kst) {
        const int sub = kst >> 1, s2 = kst & 1;
        uint4 pk;
        pk.x = pack_bf16(sacc[sub][8 * s2 + 0], sacc[sub][8 * s2 + 1]);
        pk.y = pack_bf16(sacc[sub][8 * s2 + 2], sacc[sub][8 * s2 + 3]);
        pk.z = pack_bf16(sacc[sub][8 * s2 + 4], sacc[sub][8 * s2 + 5]);
        pk.w = pack_bf16(sacc[sub][8 * s2 + 6], sacc[sub][8 * s2 + 7]);
        const bf16x8 pf = __builtin_bit_cast(bf16x8, pk);
#pragma unroll
        for (int d = 0; d < 4; ++d) {
          const bf16x8 vf = *(const bf16x8*)(v_s + (d * 32 + r) * 128 + (((2 * kst + hh) ^ sw) << 4));
          O[d] = MFMA32(vf, pf, O[d]);
        }
      }
      asm volatile("s_waitcnt vmcnt(0)" ::: "memory");
      __syncthreads();
    }
    const float lt = l_i + __shfl_xor(l_i, 32, 64);
    const float inv = 1.f / lt;
    if (m == 0) {
      u16* orow0 = p.mixed + tokq * DM + h * 128;
#pragma unroll
      for (int d = 0; d < 4; ++d)
#pragma unroll
        for (int g = 0; g < 4; ++g) {
          uint2 ov;
          ov.x = pack_bf16(O[d][4 * g + 0] * inv, O[d][4 * g + 1] * inv);
          ov.y = pack_bf16(O[d][4 * g + 2] * inv, O[d][4 * g + 3] * inv);
          *(uint2*)(orow0 + d * 32 + 8 * g + 4 * hh) = ov;
        }
    } else {
      const float li = lam * inv;
      const u16* orow0 = p.mixed + tokq * DM + h * 128;
#pragma unroll
      for (int d = 0; d < 4; ++d)
#pragma unroll
        for (int g = 0; g < 4; ++g) {
          const uint2 ov = *(const uint2*)(orow0 + d * 32 + 8 * g + 4 * hh);
          O[d][4 * g + 0] = bf_lo(ov.x) - O[d][4 * g + 0] * li;
          O[d][4 * g + 1] = bf_hi(ov.x) - O[d][4 * g + 1] * li;
          O[d][4 * g + 2] = bf_lo(ov.y) - O[d][4 * g + 2] * li;
          O[d][4 * g + 3] = bf_hi(ov.y) - O[d][4 * g + 3] * li;
        }
      float ss = 0.f;
#pragma unroll
      for (int d = 0; d < 4; ++d)
#pragma unroll
        for (int i = 0; i < 16; ++i) ss += O[d][i] * O[d][i];
      ss += __shfl_xor(ss, 32, 64);
      const float rms = rsqrtf(ss * (1.f / 128.f) + 1e-5f) * one_minus_li;
      const float* sg = p.subln_g + l * 128;
      const u16* zrow = p.pbuf + tokq * PS + PC_ZATT + h * 128;
      u16* orow = p.mixed + tokq * DM + h * 128;
#pragma unroll
      for (int d = 0; d < 4; ++d)
#pragma unroll
        for (int g = 0; g < 4; ++g) {
          const int dv = d * 32 + 8 * g + 4 * hh;
          const uint2 zz = *(const uint2*)(zrow + dv);
          const float4 gg = *(const float4*)(sg + dv);
          const float o0 = O[d][4 * g + 0] * rms * gg.x * silu(bf_lo(zz.x));
          const float o1 = O[d][4 * g + 1] * rms * gg.y * silu(bf_hi(zz.x));
          const float o2 = O[d][4 * g + 2] * rms * gg.z * silu(bf_lo(zz.y));
          const float o3 = O[d][4 * g + 3] * rms * gg.w * silu(bf_hi(zz.y));
          uint2 ov;
          ov.x = pack_bf16(o0, o1);
          ov.y = pack_bf16(o2, o3);
          *(uint2*)(orow + dv) = ov;
        }
    }
  }
}

__device__ void mix1_phase(const Params& p, int l, char* smem, int tid, int bid) {
  if (bid < N_SCAN_ITEMS) scan_item(p, bid, smem, tid, 0, SCAN_T1 / SC_TC);
  else gemm_phase<0>(p, l, smem, tid, bid, 0, G1_SPLIT + 2, N_SCAN_ITEMS / 8);
}
__device__ void mix2_phase(const Params& p, int lc, char* smem, int tid, int bid) {
  const int l = lc & 3;
  unsigned* slot = (unsigned*)(smem + 65536);
  if (bid < N_SCAN_ITEMS) {
#ifdef PROBE_ATT_ONLY
    if (lc < 4)
#endif
    scan_item(p, bid, smem, tid, SCAN_T1 / SC_TC, SEQ / SC_TC);
    asm volatile("" : "+v"(tid));
  }
  const int lane = tid & 63;
  const float* lq = p.lam_qk + l * 256;
  const float d1 = wave_sum(lq[lane] * lq[64 + lane]);
  const float d2 = wave_sum(lq[128 + lane] * lq[192 + lane]);
  const float lambda_init = 0.8f - 0.6f * expf(-0.3f * (float)l);
  const float lam = expf(d1) - expf(d2) + lambda_init;
  const int xcd = bid & 7;
  unsigned dead = 0u;
  for (;;) {
    __syncthreads();
    if (tid == 0) {
      unsigned res = 0xffffffffu;
      for (int k = 0; k < 8; ++k) {
        const int q = (xcd + k) & 7;
        if (dead & (1u << q)) continue;
        const unsigned tk = atomicAdd(&p.ctr[lc * 8 + q], 1u);
        if (tk < 128u) { res = ((tk >> 2) << 5) | ((tk & 3u) * 8u + (unsigned)q); break; }
        dead |= 1u << q;
      }
      slot[0] = res;
    }
    __syncthreads();
    const unsigned it = slot[0];
    if (it == 0xffffffffu) break;
#ifdef PROBE_SCAN_ONLY
    if (lc >= 4) break;
#endif
    asm volatile("" : "+v"(tid));
    attn_item(p, l, (int)it, lam, 1.f - lambda_init, smem, tid);
  }
}

struct FinRaw { float y[8]; float rkr[8]; u16 pv[9]; u16 z[8]; u16 cvo[8]; };
DI void fin_load(const Params& p, FinRaw& f, int tb, int c, int lane, int hd) {
  const int tok0 = tb * 8;
  const int b = tok0 >> 12, s0 = tok0 & 4095;
  f.pv[0] = (s0 > 0) ? p.pbuf[(size_t)(tok0 - 1) * PS + PC_RW + 512 + c] : (u16)0;
#pragma unroll
  for (int i = 0; i < 8; ++i) {
    const size_t rec = (size_t)(b * 4 + hd) * SEQ + s0 + i;
    f.y[i] = p.s_v[rec * 64 + lane];
    f.rkr[i] = p.s_sc[rec * 4 + 2];
    f.pv[i + 1] = p.pbuf[(size_t)(tok0 + i) * PS + PC_RW + 512 + c];
    f.z[i] = p.pbuf[(size_t)(tok0 + i) * PS + PC_ZRW + c];
    f.cvo[i] = p.pbuf[(size_t)(tok0 + i) * PS + PC_CB + c];
  }
}
__device__ void rwkv_final_phase(const Params& p, int l, char* smem, int tid, int bid) {
  u16* stg = (u16*)smem;
  const int c = tid, lane = c & 63, hd = c >> 6;
  const float g = p.lnx_g[l * 256 + c], bta = p.lnx_b[l * 256 + c];
  const float mu_v = p.mu[l * 896 + 512 + c];
  constexpr int TB = 8;
  const int ngrp = NTOK / TB;
  FinRaw cur, nxt;
  if (bid < ngrp) fin_load(p, cur, bid, c, lane, hd);
  for (int tb = bid; tb < ngrp; tb += gridDim.x) {
    const int tok0 = tb * TB;
    if (tb + (int)gridDim.x < ngrp) fin_load(p, nxt, tb + gridDim.x, c, lane, hd);
#pragma unroll
    for (int i = 0; i < TB; ++i) {
      const float mean = wave_sum(cur.y[i]) * (1.f / 64.f);
      const float dlt = cur.y[i] - mean;
      const float var = wave_sum(dlt * dlt) * (1.f / 64.f);
      const float yn = dlt * rsqrtf(var + 64e-5f) * g + bta;
      const float pv1 = bf2f(cur.pv[i + 1]), pv0 = bf2f(cur.pv[i]);
      const float xv = pv1 + (pv0 - pv1) * mu_v;
      const float o = (yn + cur.rkr[i] * xv) * silu(bf2f(cur.z[i]));
      stg[i * 512 + 256 + c] = to_bf16(o);
      stg[i * 512 + c] = cur.cvo[i];
    }
    __syncthreads();
#pragma unroll
    for (int j = 0; j < 2; ++j) {
      const int q = tid + 256 * j, tk = q >> 6, part = q & 63;
      *(u32x4*)(p.mixed + (size_t)(tok0 + tk) * DM + 512 + part * 8) = *(const u32x4*)(stg + tk * 512 + part * 8);
    }
    __syncthreads();
    cur = nxt;
  }
}

template <bool COOP>
__global__ void __launch_bounds__(256, 2) mega(Params p, int ph_begin, int ph_end, int cvar) {
  __shared__ __attribute__((aligned(16))) char smem[SMEM_BYTES];
  XcdBarrier xb;
  if (COOP) {
    volatile unsigned* st = (volatile unsigned*)(smem + 65536 + 16);
    if (threadIdx.x == 0) { st[0] = 0u; st[1] = 0u; }
    __syncthreads();
    xb = xcd_barrier_post(p.bar, st);
  }
#ifdef PROBE_PHASE
  const int n_iter = ph_end + 4;
#else
  const int n_iter = ph_end;
#endif
  for (int itp = ph_begin; itp < n_iter; ++itp) {
    int ph = itp;
#ifdef PROBE_PHASE
    if (itp >= N_PHASES) { ph = 1 + PPL * (itp - N_PHASES) + PROBE_PHASE; cvar = 1; }
#endif
    int tid = threadIdx.x, bid = blockIdx.x;
    asm volatile("" : "+v"(tid));
    asm volatile("" : "+s"(bid));
    if (ph == 0) convert_phase(p, smem, tid, bid);
    else if (ph == N_PHASES - 1) final_norm_phase(p.out, p.final_g, tid, bid);
    else {
      const int l = (ph - 1) / PPL, s = (ph - 1) % PPL;
      switch (s) {
        case 0: norm_phase(l == 0 ? p.x : p.out, p.norm_g + l * DM, p.hbuf, tid, bid); break;
        case 1: gemm_phase<0>(p, l, smem, tid, bid, G1_SPLIT, INC / 128 - 2, 0); break;
        case 2: prep_phase(p, l, smem, tid, bid); break;
        case 3: mix1_phase(p, l, smem, tid, bid); break;
        case 4: mix2_phase(p, l + 4 * cvar, smem, tid, bid); break;
        case 5: rwkv_final_phase(p, l, smem, tid, bid); break;
        default: gemm_phase<1>(p, l, smem, tid, bid, 0, DM / 128, 0); break;
      }
    }
    if (COOP && itp + 1 < n_iter) {
      if (ph_end > 4096) cg::this_grid().sync();
      xcd_barrier(xb);
    }
  }
}

extern "C" void kernel_launch(void* const* d_in, const int* in_sizes, int n_in, void* d_out, int out_size, void* d_ws,
                              size_t ws_size, hipStream_t stream) {
  Params p{};
  const float* const* in = (const float* const*)d_in;
  p.x = in[0]; p.norm_g = in[1]; p.w_in = in[2]; p.w_out = in[3]; p.final_g = in[4]; p.rel_bias = in[5];
  p.lam_qk = in[6]; p.subln_g = in[7]; p.conv_w = in[8]; p.mu = in[9]; p.w0 = in[10]; p.w_up = in[11];
  p.a0 = in[12]; p.a_up = in[13]; p.k_k = in[14]; p.k_a = in[15]; p.r_k = in[16]; p.lnx_g = in[17]; p.lnx_b = in[18];
  p.out = (float*)d_out;
  char* ws = (char*)d_ws;
  size_t off = 0;
  p.bar = (unsigned*)(ws + off); off += 16384;
  p.ctr = (unsigned*)(ws + off); off += 65536 - 16384;
  p.wt_in = (u16*)(ws + off); off += (size_t)DEPTH * INC * DM * 2;
  p.wt_out = (u16*)(ws + off); off += (size_t)DEPTH * DM * DM * 2;
  p.pbuf = (u16*)(ws + off); off += (size_t)NTOK * PS * 2;
  p.vT = (u16*)(ws + off); off += (size_t)NTOK * 512 * 2;
  p.mixed = (u16*)(ws + off); off += (size_t)NTOK * DM * 2;
  p.hbuf = p.mixed;
  p.s_kk = (u16*)(ws + off); off += (size_t)NTOK * 256 * 2;
  p.s_bb = (u16*)(ws + off); off += (size_t)NTOK * 256 * 2;
  p.s_kx = (u16*)(ws + off); off += (size_t)NTOK * 256 * 2;
  p.s_wr = (u16*)(ws + off); off += (size_t)NTOK * 256 * 2;
  p.s_w = (float*)(ws + off); off += (size_t)NTOK * 256 * 4;
  p.s_v = (float*)(ws + off); off += (size_t)NTOK * 256 * 4;
  p.s_sc = (float*)(ws + off); off += (size_t)NTOK * 4 * 4 * 4;
  p.s_state = (float*)(ws + off); off += (size_t)N_SCAN_ITEMS * 256 * 4 * 4;
  if (off > ws_size) { fprintf(stderr, "workspace too small: need %zu have %zu\n", off, ws_size); return; }

  static int grid_blocks = 0;
  if (!grid_blocks) {
    int dev = 0, cus = 0, per_cu = 0;
    hipGetDevice(&dev);
    hipDeviceGetAttribute(&cus, hipDeviceAttributeMultiprocessorCount, dev);
#if ONE_LAUNCH
    hipOccupancyMaxActiveBlocksPerMultiprocessor(&per_cu, mega<true>, 256, 0);
#else
    hipOccupancyMaxActiveBlocksPerMultiprocessor(&per_cu, mega<false>, 256, 0);
#endif
    if (per_cu > 2) per_cu = 2;
    if (per_cu < 1) per_cu = 1;
    grid_blocks = cus * per_cu;
  }
#if ONE_LAUNCH
  hipMemsetAsync(p.bar, 0, 16384, stream);
  int b0 = 0, b1 = N_PHASES, cv = 0;
  void* args[] = {&p, &b0, &b1, &cv};
  hipError_t e = hipLaunchCooperativeKernel((void*)mega<true>, dim3(grid_blocks), dim3(256), args, 0, stream);
  if (e != hipSuccess) fprintf(stderr, "cooperative launch failed: %s (grid %d)\n", hipGetErrorString(e), grid_blocks);
#else
  for (int ph = 0; ph < N_PHASES; ++ph)
    hipLaunchKernelGGL(mega<false>, dim3(grid_blocks), dim3(256), 0, stream, p, ph, ph + 1, 0);
#ifdef PROBE_PHASE
  {
    Params q = p;
    q.out = (float*)p.pbuf; q.x = (const float*)p.pbuf;
    for (int l = 0; l < DEPTH; ++l) {
      const int ph = 1 + PPL * l + PROBE_PHASE;
      hipLaunchKernelGGL(mega<false>, dim3(grid_blocks), dim3(256), 0, stream, (PROBE_PHASE == 5 || PROBE_PHASE == 0) ? q : p, ph, ph + 1, 1);
    }
  }
#endif
#endif
}
```

```cpp
#include <hip/hip_runtime.h>
#include <hip/hip_cooperative_groups.h>
#include <cstdio>
#include <cstdint>
namespace cg = cooperative_groups;

#ifndef ONE_LAUNCH
#define ONE_LAUNCH 1
#endif

typedef unsigned short u16;
typedef __bf16 bf2_t __attribute__((ext_vector_type(2)));
typedef float f2_t __attribute__((ext_vector_type(2)));
using bf16x8 = __attribute__((ext_vector_type(8))) short;
using f32x16 = __attribute__((ext_vector_type(16))) float;
using u32x4 = __attribute__((ext_vector_type(4))) unsigned;
#define DI __device__ __forceinline__
#define MFMA32(a, b, c) __builtin_amdgcn_mfma_f32_32x32x16_bf16((a), (b), (c), 0, 0, 0)

constexpr int NB = 8, SEQ = 4096, DM = 1024, DEPTH = 4, NTOK = NB * SEQ;
constexpr int INC = 4224, PS = 3712;
constexpr int PC_Q = 0, PC_K = 512, PC_ZATT = 1024, PC_CB = 1536, PC_CC = 1792, PC_CH = 2048, PC_ZCONV = 2304,
              PC_RW = 2560, PC_ZRW = 3456;
constexpr int SMEM_BYTES = 65536 + 1024;
constexpr int PPL = 7;
constexpr int N_PHASES = 2 + PPL * DEPTH;
constexpr int SCAN_T1 = 1344;
constexpr int G1_SPLIT = 16;
constexpr int N_SCAN_ITEMS = 128, N_ATT_ITEMS = 1024;

struct Params {
  const float *x, *norm_g, *w_in, *w_out, *final_g, *rel_bias, *lam_qk, *subln_g, *conv_w, *mu, *w0, *w_up, *a0,
      *a_up, *k_k, *k_a, *r_k, *lnx_g, *lnx_b;
  float* out;
  u16 *wt_in, *wt_out, *hbuf, *pbuf, *vT, *mixed;
  u16 *s_kk, *s_bb, *s_kx, *s_wr;
  float *s_w, *s_v, *s_sc, *s_state;
  unsigned *ctr, *bar;
};

DI unsigned pack_bf16(float a, float b) {
  f2_t v = {a, b};
  return __builtin_bit_cast(unsigned, __builtin_convertvector(v, bf2_t));
}
DI u16 to_bf16(float a) { return (u16)(pack_bf16(a, 0.f) & 0xffffu); }
DI float bf_lo(unsigned u) { return __uint_as_float(u << 16); }
DI float bf_hi(unsigned u) { return __uint_as_float(u & 0xffff0000u); }
DI float bf2f(u16 u) { return __uint_as_float(((unsigned)u) << 16); }
template <int CTRL, int RMASK>
DI float dpp_add(float v) {
  const int x = __builtin_amdgcn_update_dpp(0, __builtin_bit_cast(int, v), CTRL, RMASK, 0xF, true);
  return v + __builtin_bit_cast(float, x);
}
DI float wave_sum(float v) {
  v = dpp_add<0xB1, 0xF>(v);
  v = dpp_add<0x4E, 0xF>(v);
  v = dpp_add<0x124, 0xF>(v);
  v = dpp_add<0x128, 0xF>(v);
  v = dpp_add<0x142, 0xA>(v);
  v = dpp_add<0x143, 0xC>(v);
  return __builtin_bit_cast(float, __builtin_amdgcn_readlane(__builtin_bit_cast(int, v), 63));
}
DI int crow(int i, int h) { return (i & 3) + 8 * (i >> 2) + 4 * h; }
DI float silu(float z) { return z / (1.f + __expf(-z)); }

#define XB_TMO 128
#define XB_XCNT(j) (256 + 64 * (j))
#define XB_XSUB(j) (1280 + 64 * (j))
#define XB_XGEN(j) (2304 + 64 * (j))
#define XB_TOP 3328
#define XB_TOPGEN 3392
#define XCD_BAR_WORDS 3456
#define XB_SPIN_CAP (1u << 22)
DI unsigned xb_ld(unsigned* p) { return __hip_atomic_load(p, __ATOMIC_RELAXED, __HIP_MEMORY_SCOPE_AGENT); }
DI unsigned xb_add(unsigned* p, unsigned v) {
  return __hip_atomic_fetch_add(p, v, __ATOMIC_RELAXED, __HIP_MEMORY_SCOPE_AGENT);
}
DI unsigned xb_xcc_id() { return (unsigned)__builtin_amdgcn_s_getreg((3 << 11) | 20) & 0xFu; }
#define XB_SPIN(cond, bar)                                  \
  do {                                                      \
    unsigned _sp = 0;                                       \
    while (cond) {                                          \
      __builtin_amdgcn_s_sleep(1);                          \
      if ((++_sp & 255u) == 0u) {                           \
        if (xb_ld(&(bar)[XB_TMO])) break;                   \
        if (_sp > XB_SPIN_CAP) {                            \
          atomicAdd(&(bar)[XB_TMO], 1u);                    \
          break;                                            \
        }                                                   \
      }                                                     \
    }                                                       \
  } while (0)

struct XcdBarrier {
  unsigned* bar;
  unsigned x;
  volatile unsigned* st;
};
DI XcdBarrier xcd_barrier_post(unsigned* bar, volatile unsigned* st) {
  XcdBarrier b;
  b.bar = bar;
  b.x = xb_xcc_id();
  b.st = st;
  if (threadIdx.x == 0) (void)xb_add(&bar[XB_XCNT(b.x)], 1u);
  return b;
}
DI void xcd_barrier_complete(unsigned* bar, unsigned x, unsigned& nloc, unsigned& nx) {
  const unsigned G = gridDim.x;
  unsigned sum, cnt, mine, sp = 0u;
  for (;;) {
    sum = 0u; cnt = 0u; mine = 0u;
#pragma unroll
    for (unsigned j = 0; j < 16; ++j) {
      const unsigned c = xb_ld(&bar[XB_XCNT(j)]);
      sum += c; cnt += (c > 0u) ? 1u : 0u; mine = (j == x) ? c : mine;
    }
    if (sum == G) break;
    __builtin_amdgcn_s_sleep(1);
    if ((++sp & 255u) == 0u) {
      if (xb_ld(&bar[XB_TMO])) break;
      if (sp > XB_SPIN_CAP) { atomicAdd(&bar[XB_TMO], 1u); break; }
    }
  }
  nloc = mine > 0u ? mine : 1u;
  nx = cnt > 0u ? cnt : 1u;
}
DI void xcd_barrier(const XcdBarrier& b) {
  asm volatile("s_waitcnt vmcnt(0)" ::: "memory");
  __syncthreads();
  if (threadIdx.x == 0) {
    unsigned* bar = b.bar;
    __builtin_amdgcn_s_waitcnt(0);
    unsigned nloc = b.st[0], nx = b.st[1];
    if (nloc == 0u) { xcd_barrier_complete(bar, b.x, nloc, nx); b.st[0] = nloc; b.st[1] = nx; }
    const unsigned old = xb_add(&bar[XB_XSUB(b.x)], 1u);
    const unsigned gen = old / nloc;
    if (old + 1u == (gen + 1u) * nloc) {
      __builtin_amdgcn_fence(__ATOMIC_RELEASE, "agent");
      asm volatile("s_waitcnt vmcnt(0)" ::: "memory");
      const unsigned og = xb_add(&bar[XB_TOP], 1u);
      const unsigned tg = og / nx;
      if (og + 1u == (tg + 1u) * nx) xb_add(&bar[XB_TOPGEN], 1u);
      else XB_SPIN(xb_ld(&bar[XB_TOPGEN]) == tg, bar);
      __builtin_amdgcn_fence(__ATOMIC_ACQUIRE, "agent");
      xb_add(&bar[XB_XGEN(b.x)], 1u);
      asm volatile("s_waitcnt vmcnt(0)" ::: "memory");
    } else {
      XB_SPIN(xb_ld(&bar[XB_XGEN(b.x)]) == gen, bar);
      __builtin_amdgcn_fence(__ATOMIC_ACQUIRE, "agent");
      asm volatile("s_waitcnt vmcnt(0)" ::: "memory");
    }
  }
  __syncthreads();
}

__device__ void convert_phase(const Params& p, char* smem, int tid, int bid) {
  constexpr int T_IN = 16 * 66, T_OUT = 16 * 16, PER_L = T_IN + T_OUT;
  float* tile = (float*)smem;
  const int t = tid;
  if (bid == 0 && t < 128) p.ctr[t] = 0u;
  for (int it = bid; it < DEPTH * PER_L; it += gridDim.x) {
    const int l = it / PER_L;
    int r = it % PER_L;
    const float* src; u16* dst; int N;
    if (r < T_IN) { src = p.w_in + (size_t)l * DM * INC; dst = p.wt_in + (size_t)l * INC * DM; N = INC; }
    else { r -= T_IN; src = p.w_out + (size_t)l * DM * DM; dst = p.wt_out + (size_t)l * DM * DM; N = DM; }
    const int ntn = N / 64, kt = r / ntn, nt = r % ntn;
    {
      const int c4 = (t & 15) * 4, r0 = t >> 4;
      float4 v[4];
#pragma unroll
      for (int i = 0; i < 4; ++i) v[i] = *(const float4*)(src + (size_t)(kt * 64 + r0 + 16 * i) * N + nt * 64 + c4);
#pragma unroll
      for (int i = 0; i < 4; ++i) {
        float* d = tile + (r0 + 16 * i) * 65 + c4;
        d[0] = v[i].x; d[1] = v[i].y; d[2] = v[i].z; d[3] = v[i].w;
      }
    }
    __syncthreads();
    {
      const int n = t >> 2, kc = (t & 3) * 16;
      unsigned w[8];
#pragma unroll
      for (int j = 0; j < 8; ++j) w[j] = pack_bf16(tile[(kc + 2 * j) * 65 + n], tile[(kc + 2 * j + 1) * 65 + n]);
      uint4* d = (uint4*)(dst + (size_t)(nt * 64 + n) * DM + kt * 64 + kc);
      d[0] = make_uint4(w[0], w[1], w[2], w[3]);
      d[1] = make_uint4(w[4], w[5], w[6], w[7]);
    }
    __syncthreads();
  }
}

__device__ void norm_phase(const float* __restrict__ xin, const float* __restrict__ g, u16* __restrict__ h, int tid, int bid) {
  const int lane = tid & 63;
  const int wid = bid * 4 + (tid >> 6), nw = gridDim.x * 4;
  float4 gg[4];
#pragma unroll
  for (int i = 0; i < 4; ++i) gg[i] = ((const float4*)g)[lane + 64 * i];
  float4 v[2][4], nx[2][4];
  if (wid * 2 < NTOK) {
#pragma unroll
    for (int u = 0; u < 2; ++u)
#pragma unroll
      for (int i = 0; i < 4; ++i) v[u][i] = ((const float4*)(xin + (size_t)(wid * 2 + u) * DM))[lane + 64 * i];
  }
  for (int row = wid * 2; row < NTOK; row += nw * 2) {
    if (row + nw * 2 < NTOK) {
#pragma unroll
      for (int u = 0; u < 2; ++u)
#pragma unroll
        for (int i = 0; i < 4; ++i) nx[u][i] = ((const float4*)(xin + (size_t)(row + nw * 2 + u) * DM))[lane + 64 * i];
    }
#pragma unroll
    for (int u = 0; u < 2; ++u) {
      float ss = 0.f;
#pragma unroll
      for (int i = 0; i < 4; ++i) ss += v[u][i].x * v[u][i].x + v[u][i].y * v[u][i].y + v[u][i].z * v[u][i].z + v[u][i].w * v[u][i].w;
      ss = wave_sum(ss);
      const float rs = rsqrtf(ss * (1.f / DM) + 1e-6f);
#pragma unroll
      for (int i = 0; i < 4; ++i) {
        uint2 o;
        o.x = pack_bf16(v[u][i].x * rs * gg[i].x, v[u][i].y * rs * gg[i].y);
        o.y = pack_bf16(v[u][i].z * rs * gg[i].z, v[u][i].w * rs * gg[i].w);
        *(uint2*)(h + (size_t)(row + u) * DM + (lane + 64 * i) * 4) = o;
      }
    }
#pragma unroll
    for (int u = 0; u < 2; ++u)
#pragma unroll
      for (int i = 0; i < 4; ++i) v[u][i] = nx[u][i];
  }
}

__device__ void final_norm_phase(float* __restrict__ x, const float* __restrict__ g, int tid, int bid) {
  const int lane = tid & 63;
  const int wid = bid * 4 + (tid >> 6), nw = gridDim.x * 4;
  float4 gg[4];
#pragma unroll
  for (int i = 0; i < 4; ++i) gg[i] = ((const float4*)g)[lane + 64 * i];
  float4 v[4], nx[4];
  if (wid < NTOK) {
#pragma unroll
    for (int i = 0; i < 4; ++i) v[i] = ((const float4*)(x + (size_t)wid * DM))[lane + 64 * i];
  }
  for (int row = wid; row < NTOK; row += nw) {
    float4* xr = (float4*)(x + (size_t)row * DM);
    if (row + nw < NTOK) {
#pragma unroll
      for (int i = 0; i < 4; ++i) nx[i] = ((const float4*)(x + (size_t)(row + nw) * DM))[lane + 64 * i];
    }
    float ss = 0.f;
#pragma unroll
    for (int i = 0; i < 4; ++i) ss += v[i].x * v[i].x + v[i].y * v[i].y + v[i].z * v[i].z + v[i].w * v[i].w;
    ss = wave_sum(ss);
    const float rs = rsqrtf(ss * (1.f / DM) + 1e-6f);
#pragma unroll
    for (int i = 0; i < 4; ++i) {
      float4 o;
      o.x = v[i].x * rs * gg[i].x; o.y = v[i].y * rs * gg[i].y; o.z = v[i].z * rs * gg[i].z; o.w = v[i].w * rs * gg[i].w;
      xr[lane + 64 * i] = o;
    }
#pragma unroll
    for (int i = 0; i < 4; ++i) v[i] = nx[i];
  }
}

#define LAS __attribute__((address_space(3)))
template <int MODE>
__device__ void gemm_phase(const Params& p, int l, char* smem, int tid, int bid, int nt_lo, int nt_hi, int local_skip) {
  constexpr int K = DM, BK = 32, NKT = K / BK;
  constexpr int N = MODE == 0 ? INC : DM;
  constexpr int NT = N / 128;
  constexpr int STAGE = 24576;
  const u16* __restrict__ A = MODE == 0 ? p.hbuf : p.mixed;
  const u16* __restrict__ Wt = MODE == 0 ? p.wt_in + (size_t)l * INC * DM : p.wt_out + (size_t)l * DM * DM;
  LAS char* lds = (LAS char*)smem;
  const int lane = tid & 63, w = tid >> 6, r = lane & 31, hh = lane >> 5;
  const int wm = w >> 1, wn = w & 1;
  const int sw = (r >> 2) & 3;
  const int drow = lane >> 2;
  const int dcol = ((lane & 3) ^ ((drow >> 2) & 3)) * 8;
  const int xcd = bid & 7, local = (bid >> 3) - local_skip;
  const int nlocal = ((gridDim.x - xcd + 7) >> 3) - local_skip;
  const int NTR = nt_hi - nt_lo;
  (void)NT;
  for (int j = local; j < 16 * NTR; j += nlocal) {
    const int pnl = j / (8 * NTR), rr = j % (8 * NTR);
    int nt = nt_lo + (rr >> 3);
    if (MODE == 0 && nt_lo == 0 && nt >= G1_SPLIT) nt += INC / 128 - 2 - G1_SPLIT;
    const int mt = 16 * xcd + 8 * pnl + (rr & 7);
    const int m0 = mt * 256, n0 = nt * 128;
    const int wu = __builtin_amdgcn_readfirstlane(w);
    const unsigned loff = (unsigned)(drow * K + dcol);
    const u16* gbase[6];
#pragma unroll
    for (int q = 0; q < 6; ++q) {
      const int G = wu * 6 + q;
      gbase[q] = (G < 16) ? A + (size_t)(m0 + G * 16) * K : Wt + (size_t)(n0 + (G - 16) * 16) * K;
    }
#define gsrc_(q) (gbase[q] + loff)
    f32x16 acc[4][2];
#pragma unroll
    for (int a = 0; a < 4; ++a)
#pragma unroll
      for (int b = 0; b < 2; ++b)
#pragma unroll
        for (int i = 0; i < 16; ++i) acc[a][b][i] = 0.f;
#define GEMM_DMA(stg, kt_)                                                                                   \
  do {                                                                                                       \
    _Pragma("unroll") for (int q = 0; q < 6; ++q)                                                            \
        __builtin_amdgcn_global_load_lds((const unsigned*)(gsrc_(q) + (kt_) * BK),                            \
                                         (LAS unsigned*)(lds + (stg) * STAGE + (w * 6 + q) * 1024), 16, 0, 0); \
  } while (0)
#define GEMM_FRAGS(fa_, fb_, stg, ks)                                                                        \
  do {                                                                                                       \
    const LAS char* a_s_ = lds + (stg) * STAGE;                                                              \
    const int ch_ = ((2 * (ks) + hh) ^ sw) << 4;                                                             \
    _Pragma("unroll") for (int ms = 0; ms < 4; ++ms)                                                         \
        fa_[ms] = *(const LAS bf16x8*)(a_s_ + (wm * 128 + ms * 32 + r) * 64 + ch_);                         \
    _Pragma("unroll") for (int ns = 0; ns < 2; ++ns)                                                         \
        fb_[ns] = *(const LAS bf16x8*)(a_s_ + 16384 + (wn * 64 + ns * 32 + r) * 64 + ch_);                   \
  } while (0)
#define GEMM_MMA(fa_, fb_)                                                                                   \
  do {                                                                                                       \
    __builtin_amdgcn_s_setprio(1);                                                                           \
    _Pragma("unroll") for (int ms = 0; ms < 4; ++ms)                                                         \
        _Pragma("unroll") for (int ns = 0; ns < 2; ++ns) acc[ms][ns] = MFMA32(fb_[ns], fa_[ms], acc[ms][ns]); \
    __builtin_amdgcn_s_setprio(0);                                                                           \
  } while (0)
    bf16x8 a0[4], b0[2], a1[4], b1[2];
    GEMM_DMA(0, 0);
    asm volatile("s_waitcnt vmcnt(0)" ::: "memory");
    __syncthreads();
    GEMM_DMA(1, 1);
    GEMM_FRAGS(a0, b0, 0, 0);
    for (int kt = 0; kt < NKT; ++kt) {
      const int stg = kt & 1;
      GEMM_FRAGS(a1, b1, stg, 1);
      __builtin_amdgcn_sched_barrier(0);
      GEMM_MMA(a0, b0);
      __builtin_amdgcn_sched_barrier(0);
      asm volatile("s_waitcnt vmcnt(0)" ::: "memory");
      __syncthreads();
      if (kt + 2 < NKT) GEMM_DMA(stg, kt + 2);
      if (kt + 1 < NKT) GEMM_FRAGS(a0, b0, stg ^ 1, 0);
      __builtin_amdgcn_sched_barrier(0);
      GEMM_MMA(a1, b1);
      __builtin_amdgcn_sched_barrier(0);
    }
    __syncthreads();
    if (MODE == 0) {
      char* img = smem + w * 9216;
#pragma unroll
      for (int half = 0; half < 2; ++half) {
#pragma unroll
        for (int m2 = 0; m2 < 2; ++m2)
#pragma unroll
          for (int ns = 0; ns < 2; ++ns)
#pragma unroll
            for (int g = 0; g < 4; ++g) {
              uint2 v;
              v.x = pack_bf16(acc[2 * half + m2][ns][4 * g + 0], acc[2 * half + m2][ns][4 * g + 1]);
              v.y = pack_bf16(acc[2 * half + m2][ns][4 * g + 2], acc[2 * half + m2][ns][4 * g + 3]);
              *(uint2*)(img + (m2 * 32 + r) * 144 + (ns * 32 + 8 * g + 4 * hh) * 2) = v;
            }
        asm volatile("s_waitcnt lgkmcnt(0)" ::: "memory");
        const int tb = m0 + wm * 128 + half * 64;
        if (n0 >= 1024 && n0 < 1536) {
          const u16* im = (const u16*)img;
          const int bb = tb >> 12, sq = tb & 4095;
          const int c = lane & 7;
#pragma unroll
          for (int jj = 0; jj < 8; ++jj) {
            const int n = (lane >> 3) + 8 * jj;
            const int dv = n0 - 1024 + wn * 64 + n;
            unsigned e[8];
#pragma unroll
            for (int q = 0; q < 8; ++q)
              e[q] = im[(16 * (c >> 1) + 4 * (c & 1) + (q & 3) + 8 * (q >> 2)) * 72 + n];
            u32x4 v;
            v.x = e[0] | (e[1] << 16); v.y = e[2] | (e[3] << 16); v.z = e[4] | (e[5] << 16); v.w = e[6] | (e[7] << 16);
            *(u32x4*)(p.vT + ((size_t)((bb * 4 + (dv >> 7)) * 128 + (dv & 127))) * SEQ + sq + 8 * c) = v;
          }
        } else {
          const int colb = (n0 < 1024 ? n0 : n0 - 512) + wn * 64 + (lane & 7) * 8;
#pragma unroll
          for (int jj = 0; jj < 8; ++jj) {
            const int row = (lane >> 3) + 8 * jj;
            const u32x4 v = *(const u32x4*)(img + row * 144 + (lane & 7) * 16);
            *(u32x4*)(p.pbuf + (size_t)(tb + row) * PS + colb) = v;
          }
        }
        if (half == 1) __syncthreads(); else asm volatile("s_waitcnt lgkmcnt(0)" ::: "memory");
      }
    } else {
      const float* xold = (l == 0) ? p.x : p.out;
      float* img = (float*)(smem + w * 8704);
      const size_t idx0 = (size_t)(m0 + wm * 128 + (lane >> 4)) * DM + n0 + wn * 64 + (lane & 15) * 4;
      float4 xc[8], xn[8];
#pragma unroll
      for (int jj = 0; jj < 8; ++jj) xc[jj] = *(const float4*)(xold + idx0 + (size_t)(4 * jj) * DM);
#pragma unroll
      for (int ms = 0; ms < 4; ++ms) {
        if (ms < 3) {
#pragma unroll
          for (int jj = 0; jj < 8; ++jj) xn[jj] = *(const float4*)(xold + idx0 + (size_t)((ms + 1) * 32 + 4 * jj) * DM);
        }
#pragma unroll
        for (int ns = 0; ns < 2; ++ns)
#pragma unroll
          for (int g = 0; g < 4; ++g)
            *(float4*)(img + r * 68 + ns * 32 + 8 * g + 4 * hh) =
                make_float4(acc[ms][ns][4 * g + 0], acc[ms][ns][4 * g + 1], acc[ms][ns][4 * g + 2], acc[ms][ns][4 * g + 3]);
        asm volatile("s_waitcnt lgkmcnt(0)" ::: "memory");
#pragma unroll
        for (int jj = 0; jj < 8; ++jj) {
          const int row = (lane >> 4) + 4 * jj, chunk = lane & 15;
          const float4 a4 = *(const float4*)(img + row * 68 + chunk * 4);
          float4 x = xc[jj];
          x.x += a4.x; x.y += a4.y; x.z += a4.z; x.w += a4.w;
          *(float4*)(p.out + idx0 + (size_t)(ms * 32 + 4 * jj) * DM) = x;
        }
        if (ms == 3) __syncthreads(); else asm volatile("s_waitcnt lgkmcnt(0)" ::: "memory");
#pragma unroll
        for (int jj = 0; jj < 8; ++jj) xc[jj] = xn[jj];
      }
    }
  }
}

struct PrepRaw { u16 r, k, v, l, cb, cc, ch, z; };
DI void prep_load(PrepRaw& n, const u16* q, int c, int lcol) {
  n.r = q[PC_RW + c]; n.k = q[PC_RW + 256 + c]; n.v = q[PC_RW + 512 + c]; n.l = q[lcol];
  n.cb = q[PC_CB + c]; n.cc = q[PC_CC + c]; n.ch = q[PC_CH + c]; n.z = q[PC_ZCONV + c];
}
using f32x4v = __attribute__((ext_vector_type(4))) float;
#define MFMA16(a, b, c) __builtin_amdgcn_mfma_f32_16x16x32_bf16((a), (b), (c), 0, 0, 0)
__device__ void prep_phase(const Params& p, int l, char* smem, int tid, int bid) {
  u16* Xs = (u16*)smem;
  float* DWs = (float*)(smem + 8192);
  float* DAs = (float*)(smem + 24832);
  const int c = tid, lane = c & 63, hd = c >> 6;
  const int quad = lane >> 4, l15 = lane & 15;
  bf16x8 wf[4][2], af[4][2];
  {
    const float* wu = p.w_up + (size_t)l * 64 * 256;
    const float* au = p.a_up + (size_t)l * 64 * 256;
#pragma unroll
    for (int nt = 0; nt < 4; ++nt)
#pragma unroll
      for (int ks = 0; ks < 2; ++ks) {
        const int ch = 64 * hd + 16 * nt + l15, k0 = ks * 32 + quad * 8;
        u32x4 tw, ta;
        tw.x = pack_bf16(wu[(k0 + 0) * 256 + ch], wu[(k0 + 1) * 256 + ch]);
        tw.y = pack_bf16(wu[(k0 + 2) * 256 + ch], wu[(k0 + 3) * 256 + ch]);
        tw.z = pack_bf16(wu[(k0 + 4) * 256 + ch], wu[(k0 + 5) * 256 + ch]);
        tw.w = pack_bf16(wu[(k0 + 6) * 256 + ch], wu[(k0 + 7) * 256 + ch]);
        ta.x = pack_bf16(au[(k0 + 0) * 256 + ch], au[(k0 + 1) * 256 + ch]);
        ta.y = pack_bf16(au[(k0 + 2) * 256 + ch], au[(k0 + 3) * 256 + ch]);
        ta.z = pack_bf16(au[(k0 + 4) * 256 + ch], au[(k0 + 5) * 256 + ch]);
        ta.w = pack_bf16(au[(k0 + 6) * 256 + ch], au[(k0 + 7) * 256 + ch]);
        wf[nt][ks] = __builtin_bit_cast(bf16x8, tw);
        af[nt][ks] = __builtin_bit_cast(bf16x8, ta);
      }
  }
  const float* mu = p.mu + l * 896;
  const float mu_r = mu[c], mu_k = mu[256 + c], mu_v = mu[512 + c];
  const int xcol = c & 127, xhalf = c >> 7;
  const float mu_l = mu[768 + xcol];
  const float w0c = p.w0[l * 256 + c], a0c = p.a0[l * 256 + c], kkc = p.k_k[l * 256 + c], kac = p.k_a[l * 256 + c],
              rkc = p.r_k[l * 256 + c];
  const float cw0 = p.conv_w[l * 768 + c], cw1 = p.conv_w[l * 768 + 256 + c], cw2 = p.conv_w[l * 768 + 512 + c];
  for (int tile = bid; tile < NTOK / 64; tile += gridDim.x) {
    const int tok0 = tile * 64;
    const int b = tok0 >> 12, s0 = tok0 & 4095;
    float pr = 0.f, pk = 0.f, pv = 0.f, u1 = 0.f, u2 = 0.f;
    if (s0 > 0) {
      const u16* q = p.pbuf + (size_t)(tok0 - 1) * PS;
      pr = bf2f(q[PC_RW + c]); pk = bf2f(q[PC_RW + 256 + c]); pv = bf2f(q[PC_RW + 512 + c]);
      u1 = bf2f(q[PC_CC + c]) * bf2f(q[PC_CH + c]);
      const u16* q2 = q - PS;
      u2 = bf2f(q2[PC_CC + c]) * bf2f(q2[PC_CH + c]);
    }
    u16 raw[9], rawn[9];
    {
      const int tb = tok0 + 8 * xhalf;
      const u16* q = p.pbuf + (size_t)tb * PS + PC_RW + 768 + xcol;
      raw[0] = ((tb & 4095) > 0) ? *(q - PS) : (u16)0;
#pragma unroll
      for (int e = 0; e < 8; ++e) raw[e + 1] = q[(size_t)e * PS];
    }
    PrepRaw cur4[4], nxt4[4];
#pragma unroll
    for (int i4 = 0; i4 < 4; ++i4) prep_load(cur4[i4], p.pbuf + (size_t)(tok0 + i4) * PS, c, PC_RW + c);
    for (int st = 0; st < 4; ++st) {
      const int T0 = tok0 + 16 * st;
      {
        if (st < 3) {
          const int tb = T0 + 16 + 8 * xhalf;
          const u16* q = p.pbuf + (size_t)tb * PS + PC_RW + 768 + xcol;
          rawn[0] = *(q - PS);
#pragma unroll
          for (int e = 0; e < 8; ++e) rawn[e + 1] = q[(size_t)e * PS];
        }
#pragma unroll
        for (int e = 0; e < 8; ++e) {
          const float cur = bf2f(raw[e + 1]), prv = bf2f(raw[e]);
          const float xl = cur + (prv - cur) * mu_l;
          const float val = (xcol < 64) ? (1.f - 2.f / (1.f + __expf(2.f * xl))) : xl;
          Xs[(8 * xhalf + e) * 136 + xcol] = to_bf16(val);
        }
#pragma unroll
        for (int e = 0; e < 9; ++e) raw[e] = rawn[e];
      }
      __syncthreads();
      {
        bf16x8 xa[4];
#pragma unroll
        for (int k4 = 0; k4 < 4; ++k4) xa[k4] = *(const bf16x8*)(Xs + l15 * 136 + k4 * 32 + quad * 8);
#pragma unroll
        for (int nt = 0; nt < 4; ++nt) {
          f32x4v dw = {0.f, 0.f, 0.f, 0.f}, da = {0.f, 0.f, 0.f, 0.f};
          dw = MFMA16(xa[0], wf[nt][0], dw);
          dw = MFMA16(xa[1], wf[nt][1], dw);
          da = MFMA16(xa[2], af[nt][0], da);
          da = MFMA16(xa[3], af[nt][1], da);
          const int ch = 64 * hd + 16 * nt + l15;
#pragma unroll
          for (int j = 0; j < 4; ++j) {
            DWs[(quad * 4 + j) * 260 + ch] = dw[j];
            DAs[(quad * 4 + j) * 260 + ch] = da[j];
          }
        }
      }
      __syncthreads();
      u16* SB = (u16*)(smem + 41472);
      float* SF = (float*)(smem + 41472 + 8192);
      u16* SCV = (u16*)(smem + 41472 + 16384);
      float* SSC = (float*)(smem + 41472 + 18432);
      for (int g = 0; g < 4; ++g) {
        if (g < 3 || st < 3) {
#pragma unroll
          for (int i4 = 0; i4 < 4; ++i4) prep_load(nxt4[i4], p.pbuf + (size_t)(T0 + 4 * g + 4 + i4) * PS, c, PC_RW + c);
        }
#pragma unroll
        for (int i4 = 0; i4 < 4; ++i4) {
          const int i = g * 4 + i4;
          const int tok = T0 + i;
          const PrepRaw nx = cur4[i4];
          const float cr = bf2f(nx.r), ck = bf2f(nx.k), cv = bf2f(nx.v);
          const float ccb = bf2f(nx.cb), ccc = bf2f(nx.cc), cch = bf2f(nx.ch), cz = bf2f(nx.z);
          {
            const float uu = ccc * cch;
            const float y = cw0 * u2 + cw1 * u1 + cw2 * uu;
            u2 = u1; u1 = uu;
            SCV[i4 * 256 + c] = to_bf16(ccb * y * silu(cz));
          }
          const float xr = cr + (pr - cr) * mu_r, xk = ck + (pk - ck) * mu_k, xv = cv + (pv - cv) * mu_v;
          pr = cr; pk = ck; pv = cv;
          const float dws = DWs[i * 260 + c], das = DAs[i * 260 + c];
          const float wz = -(w0c + dws);
          const float sp = (wz > 20.f) ? wz : __logf(1.f + __expf(wz));
          const float decay = __expf(-__expf(-sp - 0.5f));
          const float a = 1.f / (1.f + __expf(-(a0c + das)));
          const float kkv = xk * kkc;
          const float ssq = wave_sum(kkv * kkv);
          const float kk = kkv / fmaxf(sqrtf(ssq), 1e-12f);
          const float kmod = xk * (1.f + (a - 1.f) * kac);
          const float bb = kk * a;
          const float wr = decay * xr;
          const float br = wave_sum(bb * xr);
          const float kr = wave_sum(kmod * xr);
          const float rkr = wave_sum(xr * kmod * rkc);
          SB[(0 * 4 + i4) * 256 + c] = to_bf16(kk);
          SB[(1 * 4 + i4) * 256 + c] = to_bf16(bb);
          SB[(2 * 4 + i4) * 256 + c] = to_bf16(kmod);
          SB[(3 * 4 + i4) * 256 + c] = to_bf16(wr);
          SF[(0 * 4 + i4) * 256 + c] = decay;
          SF[(1 * 4 + i4) * 256 + c] = xv;
          if (lane == 0) {
            *(float4*)(SSC + (i4 * 4 + hd) * 8) = make_float4(br, kr, rkr, 0.f);
          }
        }
        __syncthreads();
        {
          const int tg = s0 + 16 * st + 4 * g;
          {
            const int sel = tid >> 7, q = tid & 127, pr_ = q >> 3, part = q & 7;
            const int tk = pr_ >> 2, hq = pr_ & 3;
            const size_t rec = (size_t)(b * 4 + hq) * SEQ + tg + tk;
            const u32x4 v0 = *(const u32x4*)(SB + ((2 * sel) * 4 + tk) * 256 + hq * 64 + part * 8);
            const u32x4 v1 = *(const u32x4*)(SB + ((2 * sel + 1) * 4 + tk) * 256 + hq * 64 + part * 8);
            u16* d0 = sel ? p.s_kx : p.s_kk;
            u16* d1 = sel ? p.s_wr : p.s_bb;
            *(u32x4*)(d0 + rec * 64 + part * 8) = v0;
            *(u32x4*)(d1 + rec * 64 + part * 8) = v1;
          }
          {
            const int pr_ = tid >> 4, part = tid & 15;
            const int tk = pr_ >> 2, hq = pr_ & 3;
            const size_t rec = (size_t)(b * 4 + hq) * SEQ + tg + tk;
            *(u32x4*)(p.s_w + rec * 64 + part * 4) = *(const u32x4*)(SF + (0 * 4 + tk) * 256 + hq * 64 + part * 4);
            *(u32x4*)(p.s_v + rec * 64 + part * 4) = *(const u32x4*)(SF + (1 * 4 + tk) * 256 + hq * 64 + part * 4);
          }
          if (tid < 128) {
            const int tk = tid >> 5, part = tid & 31;
            *(u32x4*)(p.pbuf + (size_t)(T0 + 4 * g + tk) * PS + PC_CB + part * 8) = *(const u32x4*)(SCV + tk * 256 + part * 8);
          } else if (tid < 144) {
            const int pr_ = tid - 128;
            const int tk = pr_ >> 2, hq = pr_ & 3;
            const size_t rec = (size_t)(b * 4 + hq) * SEQ + tg + tk;
            *(float4*)(p.s_sc + rec * 4) = *(const float4*)(SSC + pr_ * 8);
          }
        }
        __syncthreads();
#pragma unroll
        for (int i4 = 0; i4 < 4; ++i4) cur4[i4] = nxt4[i4];
      }
    }
    __syncthreads();
  }
}

DI float dpp_xor1(float v) {
  return __builtin_bit_cast(float, __builtin_amdgcn_update_dpp(0, __builtin_bit_cast(int, v), 0xB1, 0xF, 0xF, true));
}
DI float dpp_xor2(float v) {
  return __builtin_bit_cast(float, __builtin_amdgcn_update_dpp(0, __builtin_bit_cast(int, v), 0x4E, 0xF, 0xF, true));
}
constexpr int SC_STEP = 340, SC_TC = 16, SC_BUF = SC_STEP * SC_TC;
struct ScanRegs { u32x4 a, b, w, v; float4 sc; };

DI void scan_load(const Params& p, int bh, int quarter, int chunk, int tid, ScanRegs& R) {
  const size_t base = ((size_t)bh * SEQ + chunk * SC_TC) * 64;
  const int c = tid & 127;
  const u16* pa = (tid < 128) ? p.s_kk : p.s_bb;
  const u16* pb = (tid < 128) ? p.s_kx : p.s_wr;
  R.a = *(const u32x4*)(pa + base + c * 8);
  R.b = *(const u32x4*)(pb + base + c * 8);
  R.w = *(const u32x4*)(p.s_w + base + tid * 4);
  if (tid < 64) {
    const int st = tid >> 2, q = tid & 3;
    R.v = *(const u32x4*)(p.s_v + base + st * 64 + quarter * 16 + q * 4);
  } else if (tid >= 128 && tid < 144) {
    R.sc = *(const float4*)(p.s_sc + ((size_t)bh * SEQ + chunk * SC_TC + (tid - 128)) * 4);
  }
}
DI void scan_cvt_store(float* d, u32x4 u) {
  *(float4*)(d) = make_float4(bf_lo(u.x), bf_hi(u.x), bf_lo(u.y), bf_hi(u.y));
  *(float4*)(d + 4) = make_float4(bf_lo(u.z), bf_hi(u.z), bf_lo(u.w), bf_hi(u.w));
}
DI void scan_store(float* buf, int tid, const ScanRegs& R) {
  {
    const int c = tid & 127, st = c >> 3, q = c & 7;
    float* d = buf + st * SC_STEP + q * 8;
    scan_cvt_store(d + (tid < 128 ? 0 : 64), R.a);
    scan_cvt_store(d + (tid < 128 ? 192 : 256), R.b);
  }
  {
    const int e = tid * 4;
    *(u32x4*)(buf + (e >> 6) * SC_STEP + 128 + (e & 63)) = R.w;
  }
  if (tid < 64) {
    const int st = tid >> 2, q = tid & 3;
    *(u32x4*)(buf + st * SC_STEP + 320 + q * 4) = R.v;
  } else if (tid >= 128 && tid < 144) {
    *(float4*)(buf + (tid - 128) * SC_STEP + 336) = R.sc;
  }
}

struct StepOps { f2_t kk[2], bb[2], ww[2], kx[2], wr[2]; float vv; f2_t bk; };
DI void step_load(StepOps& o, const float* sb, int kq, int row) {
  const f2_t* q = (const f2_t*)(sb + kq * 4);
#pragma unroll
  for (int j = 0; j < 2; ++j) {
    o.kk[j] = q[j];
    o.bb[j] = q[32 + j];
    o.ww[j] = q[64 + j];
    o.kx[j] = q[96 + j];
    o.wr[j] = q[128 + j];
  }
  o.vv = sb[320 + row];
  o.bk = *(const f2_t*)(sb + 336);
}
template <int CTRL>
DI float dpp_mov(float v) {
  return __builtin_bit_cast(float, __builtin_amdgcn_update_dpp(0, __builtin_bit_cast(int, v), CTRL, 0xF, 0xF, true));
}
DI void step_compute(f2_t (&S)[2], const StepOps& o, float& ykeep, bool keep) {
  f2_t sa2 = S[0] * o.kk[0], yd2 = S[0] * o.wr[0];
  sa2 += S[1] * o.kk[1];
  yd2 += S[1] * o.wr[1];
  float sa = sa2.x + sa2.y, yd = yd2.x + yd2.y;
  sa += dpp_mov<0xB1>(sa); yd += dpp_mov<0xB1>(yd);
  sa += dpp_mov<0x4E>(sa); yd += dpp_mov<0x4E>(yd);
  sa += dpp_mov<0x124>(sa); yd += dpp_mov<0x124>(yd);
  sa += dpp_mov<0x128>(sa); yd += dpp_mov<0x128>(yd);
  const f2_t vv2 = {o.vv, o.vv}, sa2b = {sa, sa};
#pragma unroll
  for (int j = 0; j < 2; ++j) {
    f2_t t = vv2 * o.kx[j];
    t = t - sa2b * o.bb[j];
    S[j] = S[j] * o.ww[j] + t;
  }
  const float y = yd - sa * o.bk.x + o.vv * o.bk.y;
  ykeep = keep ? y : ykeep;
}

__device__ void scan_item(const Params& p, int item, char* smem, int tid, int ch0, int ch1) {
  float* lds = (float*)smem;
  const int bh = item >> 2, quarter = item & 3;
  const int w = tid >> 6, lane = tid & 63;
  const int NCH = SEQ / SC_TC;
  ScanRegs R;
  f2_t S[2];
  float4* const stp = (float4*)(p.s_state) + (size_t)item * 256 + tid;
  if (ch0 == 0) {
    S[0] = f2_t{0.f, 0.f};
    S[1] = f2_t{0.f, 0.f};
  } else {
    const float4 sv = *stp;
    S[0] = f2_t{sv.x, sv.y};
    S[1] = f2_t{sv.z, sv.w};
  }
  const int row = (lane >> 4) + 4 * w;
  const int kq = lane & 15;
  __syncthreads();
  (void)NCH;
  scan_load(p, bh, quarter, ch0, tid, R);
  scan_store(lds + (ch0 & 1) * SC_BUF, tid, R);
  scan_load(p, bh, quarter, ch0 + 1, tid, R);
  __syncthreads();
  for (int ch = ch0; ch < ch1; ++ch) {
    const float* buf = lds + (ch & 1) * SC_BUF;
    if (ch + 1 < ch1) scan_store(lds + ((ch + 1) & 1) * SC_BUF, tid, R);
    if (ch + 2 < ch1) scan_load(p, bh, quarter, ch + 2, tid, R);
    float ykeep = 0.f;
    StepOps o0, o1;
    step_load(o0, buf, kq, row);
#pragma unroll
    for (int st = 0; st < SC_TC; st += 2) {
      step_load(o1, buf + (st + 1) * SC_STEP, kq, row);
      step_compute(S, o0, ykeep, kq == st);
      if (st + 2 < SC_TC) step_load(o0, buf + (st + 2) * SC_STEP, kq, row);
      step_compute(S, o1, ykeep, kq == st + 1);
    }
    p.s_v[((size_t)bh * SEQ + ch * SC_TC + kq) * 64 + quarter * 16 + row] = ykeep;
    __syncthreads();
  }
  if (ch1 < SEQ / SC_TC) *stp = make_float4(S[0].x, S[0].y, S[1].x, S[1].y);
}

DI void vstore(char* lo, char* hi, u32x4 a, u32x4 b, u32x4 c, u32x4 d) {
  *(uint2*)(lo) = make_uint2(a.x, a.y); *(uint2*)(hi) = make_uint2(a.z, a.w);
  *(uint2*)(lo + 4096) = make_uint2(b.x, b.y); *(uint2*)(hi + 4096) = make_uint2(b.z, b.w);
  *(uint2*)(lo + 8192) = make_uint2(c.x, c.y); *(uint2*)(hi + 8192) = make_uint2(c.z, c.w);
  *(uint2*)(lo + 12288) = make_uint2(d.x, d.y); *(uint2*)(hi + 12288) = make_uint2(d.z, d.w);
}
__device__ void attn_item(const Params& p, int l, int a, float lam, float one_minus_li, char* smem, int tid) {
  const int qb = 31 - (a >> 5), bhx = a & 31, b = bhx >> 2, h = bhx & 3;
  const int t = tid, lane = t & 63, w = t >> 6, r = lane & 31, hh = lane >> 5;
  const int sw = (r >> 1) & 7;
  const int q0 = qb * 128;
  const int qpos = q0 + w * 32 + r;
  const size_t tokq = (size_t)b * SEQ + qpos;
  float* lut = (float*)(smem + 49152);
  const float LOG2E = 1.4426950408889634f;
  __syncthreads();
  {
    const int d = t - 128;
    float v = -1e30f;
    if (d >= 0) {
      int bk;
      if (d < 16) bk = d;
      else {
        bk = 16 + (int)(logf((float)d / 16.f) / logf(8.f) * 16.f);
        bk = bk > 31 ? 31 : bk;
      }
      v = p.rel_bias[bk * 4 + h] * LOG2E;
    }
    lut[t] = v;
  }
  const float cbias = p.rel_bias[31 * 4 + h] * LOG2E;
  const int dq = qpos - 4 * hh;
  const float sc = 0.125f * LOG2E;
  const int ntiles = 2 * (qb + 1);
  const int lc = t & 7, lr = t >> 3;
  const unsigned ldsw = lr * 128 + ((lc ^ ((lr >> 1) & 7)) << 4);
  const int drl = lane >> 3, dpc = lane & 7;
  const int dc0 = (dpc ^ (drl >> 1)) * 8;
  const int dc1 = (dpc ^ (4 + (drl >> 1))) * 8;
  const u16* vsrc0 = p.vT + ((size_t)((b * 4 + h) * 128 + w * 32 + drl)) * SEQ;
  LAS char* ldsl = (LAS char*)smem;
  (void)lc; (void)lr; (void)ldsw;
#pragma unroll
  for (int m = 0; m < 2; ++m) {
    const u16* ksrc0 = p.pbuf + ((size_t)b * SEQ + w * 16 + drl) * PS + PC_K + h * 128 + m * 64;
    bf16x8 qf[4];
    {
      const u16* qp = p.pbuf + tokq * PS + PC_Q + h * 128 + m * 64 + hh * 8;
#pragma unroll
      for (int ks = 0; ks < 4; ++ks) qf[ks] = *(const bf16x8*)(qp + ks * 16);
    }
    f32x16 O[4];
#pragma unroll
    for (int d = 0; d < 4; ++d)
#pragma unroll
      for (int i = 0; i < 16; ++i) O[d][i] = 0.f;
    float m_i = -1e30f, l_i = 0.f;
    __syncthreads();
#define ATT_STAGE(buf, kk0)                                                                                             \
  do {                                                                                                                  \
    __builtin_amdgcn_global_load_lds((const unsigned*)(ksrc0 + (size_t)(kk0) * PS + dc0),                               \
                                     (LAS unsigned*)(ldsl + (buf) * 8192 + (w * 2) * 1024), 16, 0, 0);                  \
    __builtin_amdgcn_global_load_lds((const unsigned*)(ksrc0 + (size_t)((kk0) + 8) * PS + dc1),                         \
                                     (LAS unsigned*)(ldsl + (buf) * 8192 + (w * 2 + 1) * 1024), 16, 0, 0);              \
    _Pragma("unroll") for (int q_ = 0; q_ < 4; ++q_)                                                                   \
        __builtin_amdgcn_global_load_lds((const unsigned*)(vsrc0 + (size_t)(q_ * 8) * SEQ + (kk0) + ((q_ & 1) ? dc1 : dc0)), \
                                         (LAS unsigned*)(ldsl + 16384 + (buf) * 16384 + (w * 4 + q_) * 1024), 16, 0, 0); \
  } while (0)
    ATT_STAGE(0, 0);
    asm volatile("s_waitcnt vmcnt(0)" ::: "memory");
    __syncthreads();
    for (int kt = 0; kt < ntiles; ++kt) {
      const int k0 = kt * 64;
      if (kt + 1 < ntiles) ATT_STAGE((kt + 1) & 1, k0 + 64);
      const char* k_s = smem + (kt & 1) * 8192;
      const char* v_s = smem + 16384 + (kt & 1) * 16384;
      f32x16 sacc[2];
#pragma unroll
      for (int sub = 0; sub < 2; ++sub) {
#pragma unroll
        for (int i = 0; i < 16; ++i) sacc[sub][i] = 0.f;
#pragma unroll
        for (int ks = 0; ks < 4; ++ks) {
          const bf16x8 kf = *(const bf16x8*)(k_s + (sub * 32 + r) * 128 + (((2 * ks + hh) ^ sw) << 4));
          sacc[sub] = MFMA32(kf, qf[ks], sacc[sub]);
        }
      }
      float rs = 0.f, alpha;
      if (kt + 4 >= ntiles) {
        float mx = -1e30f;
#pragma unroll
        for (int sub = 0; sub < 2; ++sub)
#pragma unroll
          for (int i = 0; i < 16; ++i) {
            const int d = dq - k0 - (sub * 32 + (i & 3) + 8 * (i >> 2));
            const int di = d < -128 ? -128 : (d > 127 ? 127 : d);
            const float sv = sacc[sub][i] * sc + lut[di + 128];
            sacc[sub][i] = sv;
            mx = fmaxf(mx, sv);
          }
        mx = fmaxf(mx, __shfl_xor(mx, 32, 64));
        const float m_new = fmaxf(m_i, mx);
        alpha = __builtin_amdgcn_exp2f(m_i - m_new);
        m_i = m_new;
#pragma unroll
        for (int sub = 0; sub < 2; ++sub)
#pragma unroll
          for (int i = 0; i < 16; ++i) {
            const float pe = __builtin_amdgcn_exp2f(sacc[sub][i] - m_new);
            sacc[sub][i] = pe;
            rs += pe;
          }
      } else {
        float mx = -1e30f;
#pragma unroll
        for (int sub = 0; sub < 2; ++sub)
#pragma unroll
          for (int i = 0; i < 16; ++i) mx = fmaxf(mx, sacc[sub][i]);
        mx = fmaxf(mx, __shfl_xor(mx, 32, 64));
        const float m_new = fmaxf(m_i, mx * sc + cbias);
        alpha = __builtin_amdgcn_exp2f(m_i - m_new);
        m_i = m_new;
        const float off = cbias - m_new;
#pragma unroll
        for (int sub = 0; sub < 2; ++sub)
#pragma unroll
          for (int i = 0; i < 16; ++i) {
            const float pe = __builtin_amdgcn_exp2f(sacc[sub][i] * sc + off);
            sacc[sub][i] = pe;
            rs += pe;
          }
      }
      l_i = l_i * alpha + rs;
      if (__any(alpha != 1.f)) {
#pragma unroll
        for (int d = 0; d < 4; ++d)
#pragma unroll
          for (int i = 0; i < 16; ++i) O[d][i] *= alpha;
      }
#pragma unroll
      for (int kst = 0; kst < 4; ++kst) {
        const int sub = kst >> 1, s2 = kst & 1;
        uint4 pk;
        pk.x = pack_bf16(sacc[sub][8 * s2 + 0], sacc[sub][8 * s2 + 1]);
        pk.y = pack_bf16(sacc[sub][8 * s2 + 2], sacc[sub][8 * s2 + 3]);
        pk.z = pack_bf16(sacc[sub][8 * s2 + 4], sacc[sub][8 * s2 + 5]);
        pk.w = pack_bf16(sacc[sub][8 * s2 + 6], sacc[sub][8 * s2 + 7]);
        const bf16x8 pf = __builtin_bit_cast(bf16x8, pk);
#pragma unroll
        for (int d = 0; d < 4; ++d) {
          const bf16x8 vf = *(const bf16x8*)(v_s + (d * 32 + r) * 128 + (((2 * kst + hh) ^ sw) << 4));
          O[d] = MFMA32(vf, pf, O[d]);
        }
      }
      asm volatile("s_waitcnt vmcnt(0)" ::: "memory");
      __syncthreads();
    }
    const float lt = l_i + __shfl_xor(l_i, 32, 64);
    const float inv = 1.f / lt;
    if (m == 0) {
      u16* orow0 = p.mixed + tokq * DM + h * 128;
#pragma unroll
      for (int d = 0; d < 4; ++d)
#pragma unroll
        for (int g = 0; g < 4; ++g) {
          uint2 ov;
          ov.x = pack_bf16(O[d][4 * g + 0] * inv, O[d][4 * g + 1] * inv);
          ov.y = pack_bf16(O[d][4 * g + 2] * inv, O[d][4 * g + 3] * inv);
          *(uint2*)(orow0 + d * 32 + 8 * g + 4 * hh) = ov;
        }
    } else {
      const float li = lam * inv;
      const u16* orow0 = p.mixed + tokq * DM + h * 128;
#pragma unroll
      for (int d = 0; d < 4; ++d)
#pragma unroll
        for (int g = 0; g < 4; ++g) {
          const uint2 ov = *(const uint2*)(orow0 + d * 32 + 8 * g + 4 * hh);
          O[d][4 * g + 0] = bf_lo(ov.x) - O[d][4 * g + 0] * li;
          O[d][4 * g + 1] = bf_hi(ov.x) - O[d][4 * g + 1] * li;
          O[d][4 * g + 2] = bf_lo(ov.y) - O[d][4 * g + 2] * li;
          O[d][4 * g + 3] = bf_hi(ov.y) - O[d][4 * g + 3] * li;
        }
      float ss = 0.f;
#pragma unroll
      for (int d = 0; d < 4; ++d)
#pragma unroll
        for (int i = 0; i < 16; ++i) ss += O[d][i] * O[d][i];
      ss += __shfl_xor(ss, 32, 64);
      const float rms = rsqrtf(ss * (1.f / 128.f) + 1e-5f) * one_minus_li;
      const float* sg = p.subln_g + l * 128;
      const u16* zrow = p.pbuf + tokq * PS + PC_ZATT + h * 128;
      u16* orow = p.mixed + tokq * DM + h * 128;
#pragma unroll
      for (int d = 0; d < 4; ++d)
#pragma unroll
        for (int g = 0; g < 4; ++g) {
          const int dv = d * 32 + 8 * g + 4 * hh;
          const uint2 zz = *(const uint2*)(zrow + dv);
          const float4 gg = *(const float4*)(sg + dv);
          const float o0 = O[d][4 * g + 0] * rms * gg.x * silu(bf_lo(zz.x));
          const float o1 = O[d][4 * g + 1] * rms * gg.y * silu(bf_hi(zz.x));
          const float o2 = O[d][4 * g + 2] * rms * gg.z * silu(bf_lo(zz.y));
          const float o3 = O[d][4 * g + 3] * rms * gg.w * silu(bf_hi(zz.y));
          uint2 ov;
          ov.x = pack_bf16(o0, o1);
          ov.y = pack_bf16(o2, o3);
          *(uint2*)(orow + dv) = ov;
        }
    }
  }
}

__device__ void mix1_phase(const Params& p, int l, char* smem, int tid, int bid) {
  if (bid < N_SCAN_ITEMS) scan_item(p, bid, smem, tid, 0, SCAN_T1 / SC_TC);
  else gemm_phase<0>(p, l, smem, tid, bid, 0, G1_SPLIT + 2, N_SCAN_ITEMS / 8);
}
__device__ void mix2_phase(const Params& p, int lc, char* smem, int tid, int bid) {
  const int l = lc & 3;
  unsigned* slot = (unsigned*)(smem + 65536);
  if (bid < N_SCAN_ITEMS) {
#ifdef PROBE_ATT_ONLY
    if (lc < 4)
#endif
    scan_item(p, bid, smem, tid, SCAN_T1 / SC_TC, SEQ / SC_TC);
    asm volatile("" : "+v"(tid));
  }
  const int lane = tid & 63;
  const float* lq = p.lam_qk + l * 256;
  const float d1 = wave_sum(lq[lane] * lq[64 + lane]);
  const float d2 = wave_sum(lq[128 + lane] * lq[192 + lane]);
  const float lambda_init = 0.8f - 0.6f * expf(-0.3f * (float)l);
  const float lam = expf(d1) - expf(d2) + lambda_init;
  const int xcd = bid & 7;
  unsigned dead = 0u;
  for (;;) {
    __syncthreads();
    if (tid == 0) {
      unsigned res = 0xffffffffu;
      for (int k = 0; k < 8; ++k) {
        const int q = (xcd + k) & 7;
        if (dead & (1u << q)) continue;
        const unsigned tk = atomicAdd(&p.ctr[lc * 8 + q], 1u);
        if (tk < 128u) { res = ((tk >> 2) << 5) | ((tk & 3u) * 8u + (unsigned)q); break; }
        dead |= 1u << q;
      }
      slot[0] = res;
    }
    __syncthreads();
    const unsigned it = slot[0];
    if (it == 0xffffffffu) break;
#ifdef PROBE_SCAN_ONLY
    if (lc >= 4) break;
#endif
    asm volatile("" : "+v"(tid));
    attn_item(p, l, (int)it, lam, 1.f - lambda_init, smem, tid);
  }
}

struct FinRaw { float y[8]; float rkr[8]; u16 pv[9]; u16 z[8]; u16 cvo[8]; };
DI void fin_load(const Params& p, FinRaw& f, int tb, int c, int lane, int hd) {
  const int tok0 = tb * 8;
  const int b = tok0 >> 12, s0 = tok0 & 4095;
  f.pv[0] = (s0 > 0) ? p.pbuf[(size_t)(tok0 - 1) * PS + PC_RW + 512 + c] : (u16)0;
#pragma unroll
  for (int i = 0; i < 8; ++i) {
    const size_t rec = (size_t)(b * 4 + hd) * SEQ + s0 + i;
    f.y[i] = p.s_v[rec * 64 + lane];
    f.rkr[i] = p.s_sc[rec * 4 + 2];
    f.pv[i + 1] = p.pbuf[(size_t)(tok0 + i) * PS + PC_RW + 512 + c];
    f.z[i] = p.pbuf[(size_t)(tok0 + i) * PS + PC_ZRW + c];
    f.cvo[i] = p.pbuf[(size_t)(tok0 + i) * PS + PC_CB + c];
  }
}
__device__ void rwkv_final_phase(const Params& p, int l, char* smem, int tid, int bid) {
  u16* stg = (u16*)smem;
  const int c = tid, lane = c & 63, hd = c >> 6;
  const float g = p.lnx_g[l * 256 + c], bta = p.lnx_b[l * 256 + c];
  const float mu_v = p.mu[l * 896 + 512 + c];
  constexpr int TB = 8;
  const int ngrp = NTOK / TB;
  FinRaw cur, nxt;
  if (bid < ngrp) fin_load(p, cur, bid, c, lane, hd);
  for (int tb = bid; tb < ngrp; tb += gridDim.x) {
    const int tok0 = tb * TB;
    if (tb + (int)gridDim.x < ngrp) fin_load(p, nxt, tb + gridDim.x, c, lane, hd);
#pragma unroll
    for (int i = 0; i < TB; ++i) {
      const float mean = wave_sum(cur.y[i]) * (1.f / 64.f);
      const float dlt = cur.y[i] - mean;
      const float var = wave_sum(dlt * dlt) * (1.f / 64.f);
      const float yn = dlt * rsqrtf(var + 64e-5f) * g + bta;
      const float pv1 = bf2f(cur.pv[i + 1]), pv0 = bf2f(cur.pv[i]);
      const float xv = pv1 + (pv0 - pv1) * mu_v;
      const float o = (yn + cur.rkr[i] * xv) * silu(bf2f(cur.z[i]));
      stg[i * 512 + 256 + c] = to_bf16(o);
      stg[i * 512 + c] = cur.cvo[i];
    }
    __syncthreads();
#pragma unroll
    for (int j = 0; j < 2; ++j) {
      const int q = tid + 256 * j, tk = q >> 6, part = q & 63;
      *(u32x4*)(p.mixed + (size_t)(tok0 + tk) * DM + 512 + part * 8) = *(const u32x4*)(stg + tk * 512 + part * 8);
    }
    __syncthreads();
    cur = nxt;
  }
}

template <bool COOP>
__global__ void __launch_bounds__(256, 2) mega(Params p, int ph_begin, int ph_end, int cvar) {
  __shared__ __attribute__((aligned(16))) char smem[SMEM_BYTES];
  XcdBarrier xb;
  if (COOP) {
    volatile unsigned* st = (volatile unsigned*)(smem + 65536 + 16);
    if (threadIdx.x == 0) { st[0] = 0u; st[1] = 0u; }
    __syncthreads();
    xb = xcd_barrier_post(p.bar, st);
  }
#ifdef PROBE_PHASE
  const int n_iter = ph_end + 4;
#else
  const int n_iter = ph_end;
#endif
  for (int itp = ph_begin; itp < n_iter; ++itp) {
    int ph = itp;
#ifdef PROBE_PHASE
    if (itp >= N_PHASES) { ph = 1 + PPL * (itp - N_PHASES) + PROBE_PHASE; cvar = 1; }
#endif
    int tid = threadIdx.x, bid = blockIdx.x;
    asm volatile("" : "+v"(tid));
    asm volatile("" : "+s"(bid));
    if (ph == 1) continue;
    if (ph == 0) { convert_phase(p, smem, tid, bid); norm_phase(p.x, p.norm_g, p.hbuf, tid, bid); }
    else if (ph == N_PHASES - 1) final_norm_phase(p.out, p.final_g, tid, bid);
    else {
      const int l = (ph - 1) / PPL, s = (ph - 1) % PPL;
      switch (s) {
        case 0: norm_phase(l == 0 ? p.x : p.out, p.norm_g + l * DM, p.hbuf, tid, bid); break;
        case 1: gemm_phase<0>(p, l, smem, tid, bid, G1_SPLIT, INC / 128 - 2, 0); break;
        case 2: prep_phase(p, l, smem, tid, bid); break;
        case 3: mix1_phase(p, l, smem, tid, bid); break;
        case 4: mix2_phase(p, l + 4 * cvar, smem, tid, bid); break;
        case 5: rwkv_final_phase(p, l, smem, tid, bid); break;
        default: gemm_phase<1>(p, l, smem, tid, bid, 0, DM / 128, 0); break;
      }
    }
    if (COOP && itp + 1 < n_iter) {
      if (ph_end > 4096) cg::this_grid().sync();
      xcd_barrier(xb);
    }
  }
}

extern "C" void kernel_launch(void* const* d_in, const int* in_sizes, int n_in, void* d_out, int out_size, void* d_ws,
                              size_t ws_size, hipStream_t stream) {
  Params p{};
  const float* const* in = (const float* const*)d_in;
  p.x = in[0]; p.norm_g = in[1]; p.w_in = in[2]; p.w_out = in[3]; p.final_g = in[4]; p.rel_bias = in[5];
  p.lam_qk = in[6]; p.subln_g = in[7]; p.conv_w = in[8]; p.mu = in[9]; p.w0 = in[10]; p.w_up = in[11];
  p.a0 = in[12]; p.a_up = in[13]; p.k_k = in[14]; p.k_a = in[15]; p.r_k = in[16]; p.lnx_g = in[17]; p.lnx_b = in[18];
  p.out = (float*)d_out;
  char* ws = (char*)d_ws;
  size_t off = 0;
  p.bar = (unsigned*)(ws + off); off += 16384;
  p.ctr = (unsigned*)(ws + off); off += 65536 - 16384;
  p.wt_in = (u16*)(ws + off); off += (size_t)DEPTH * INC * DM * 2;
  p.wt_out = (u16*)(ws + off); off += (size_t)DEPTH * DM * DM * 2;
  p.pbuf = (u16*)(ws + off); off += (size_t)NTOK * PS * 2;
  p.vT = (u16*)(ws + off); off += (size_t)NTOK * 512 * 2;
  p.mixed = (u16*)(ws + off); off += (size_t)NTOK * DM * 2;
  p.hbuf = p.mixed;
  p.s_kk = (u16*)(ws + off); off += (size_t)NTOK * 256 * 2;
  p.s_bb = (u16*)(ws + off); off += (size_t)NTOK * 256 * 2;
  p.s_kx = (u16*)(ws + off); off += (size_t)NTOK * 256 * 2;
  p.s_wr = (u16*)(ws + off); off += (size_t)NTOK * 256 * 2;
  p.s_w = (float*)(ws + off); off += (size_t)NTOK * 256 * 4;
  p.s_v = (float*)(ws + off); off += (size_t)NTOK * 256 * 4;
  p.s_sc = (float*)(ws + off); off += (size_t)NTOK * 4 * 4 * 4;
  p.s_state = (float*)(ws + off); off += (size_t)N_SCAN_ITEMS * 256 * 4 * 4;
  if (off > ws_size) { fprintf(stderr, "workspace too small: need %zu have %zu\n", off, ws_size); return; }

  static int grid_blocks = 0;
  if (!grid_blocks) {
    int dev = 0, cus = 0, per_cu = 0;
    hipGetDevice(&dev);
    hipDeviceGetAttribute(&cus, hipDeviceAttributeMultiprocessorCount, dev);
#if ONE_LAUNCH
    hipOccupancyMaxActiveBlocksPerMultiprocessor(&per_cu, mega<true>, 256, 0);
#else
    hipOccupancyMaxActiveBlocksPerMultiprocessor(&per_cu, mega<false>, 256, 0);
#endif
    if (per_cu > 2) per_cu = 2;
    if (per_cu < 1) per_cu = 1;
    grid_blocks = cus * per_cu;
  }
#if ONE_LAUNCH
  hipMemsetAsync(p.bar, 0, 16384, stream);
  int b0 = 0, b1 = N_PHASES, cv = 0;
  void* args[] = {&p, &b0, &b1, &cv};
  hipError_t e = hipLaunchCooperativeKernel((void*)mega<true>, dim3(grid_blocks), dim3(256), args, 0, stream);
  if (e != hipSuccess) fprintf(stderr, "cooperative launch failed: %s (grid %d)\n", hipGetErrorString(e), grid_blocks);
#else
  for (int ph = 0; ph < N_PHASES; ++ph)
    hipLaunchKernelGGL(mega<false>, dim3(grid_blocks), dim3(256), 0, stream, p, ph, ph + 1, 0);
#ifdef PROBE_PHASE
  {
    Params q = p;
    q.out = (float*)p.pbuf; q.x = (const float*)p.pbuf;
    for (int l = 0; l < DEPTH; ++l) {
      const int ph = 1 + PPL * l + PROBE_PHASE;
      hipLaunchKernelGGL(mega<false>, dim3(grid_blocks), dim3(256), 0, stream, (PROBE_PHASE == 5 || PROBE_PHASE == 0) ? q : p, ph, ph + 1, 1);
    }
  }
#endif
#endif
}
```
